# Optimizing an MI355X kernel written in HIP

```python
import jax, jax.numpy as jnp
from jax import lax
import numpy as np

D_MODEL = 1024
BATCH = 8
SEQ = 2048
DEPTH = 2

N_EVEN = (DEPTH + 1) // 2
N_ODD = DEPTH // 2
EPS = 1e-6

CONV_CH = 512
CONV_WIDTH = 31
HEAD_DIM = 64
HEADS_PER_GROUP = 8
DILATED_PAIRS = ((128, 1), (512, 4), (2048, 16))
N_GROUPS = len(DILATED_PAIRS)
ATTN_HEADS = N_GROUPS * HEADS_PER_GROUP
ATTN_WIDTH = ATTN_HEADS * HEAD_DIM
ATTN_OUT = HEADS_PER_GROUP * HEAD_DIM
ROPE_THETA = 10000.0
EVEN_IN = 2 * CONV_CH + 3 * ATTN_WIDTH
EVEN_OUT = CONV_CH + ATTN_OUT
SCONV_CH = 512
SCONV_WIDTH = 3
SG_GROUPS = 4
SG_HEAD = 128
SG_CH = SG_GROUPS * SG_HEAD
CHUNK = 128
ODD_IN = 3 * SCONV_CH + 2 * SG_CH
ODD_OUT = SCONV_CH + SG_CH
D_FF = 4 * D_MODEL

kernel_name = "hybrid_conformer_dilated_shortconv_gmlp_trunk"


def rms_norm(x, g):
    xf = x.astype(jnp.float32)
    y = xf * lax.rsqrt(jnp.mean(xf * xf, axis=-1, keepdims=True) + EPS)
    return (y * g.astype(jnp.float32)).astype(x.dtype)


def layer_norm(x, g, b):
    xf = x.astype(jnp.float32)
    mu = jnp.mean(xf, axis=-1, keepdims=True)
    xc = xf - mu
    y = xc * lax.rsqrt(jnp.mean(xc * xc, axis=-1, keepdims=True) + EPS)
    return (y * g.astype(jnp.float32) + b.astype(jnp.float32)).astype(x.dtype)


def rope_tables(seq):
    half = HEAD_DIM // 2
    inv = ROPE_THETA ** (-jnp.arange(half, dtype=jnp.float32) / half)
    ang = jnp.arange(seq, dtype=jnp.float32)[:, None] * inv[None, :]
    return jnp.cos(ang), jnp.sin(ang)


def apply_rope(x, cos, sin):
    x1, x2 = jnp.split(x, 2, axis=-1)
    c = cos[None, :, None, :]
    s = sin[None, :, None, :]
    return jnp.concatenate([x1 * c - x2 * s, x2 * c + x1 * s], axis=-1).astype(x.dtype)


def causal_depthwise_conv(x, kern):
    w = kern.shape[0]
    return lax.conv_general_dilated(
        x, kern[:, None, :].astype(x.dtype), window_strides=(1,),
        padding=[(w - 1, 0)], dimension_numbers=('NWC', 'WIO', 'NWC'),
        feature_group_count=x.shape[-1])


def banded_causal_attention(q, k, v, band):
    b, r, l, h, dh = q.shape
    nb = -(-l // band)
    lp = nb * band
    pad = ((0, 0), (0, 0), (0, lp - l), (0, 0), (0, 0))
    qb = jnp.pad(q, pad).reshape(b, r, nb, band, h, dh)
    kb = jnp.pad(k, pad).reshape(b, r, nb, band, h, dh)
    vb = jnp.pad(v, pad).reshape(b, r, nb, band, h, dh)
    zk = jnp.zeros_like(kb[:, :, :1])
    k2 = jnp.concatenate([jnp.concatenate([zk, kb[:, :, :-1]], axis=2), kb], axis=3)
    v2 = jnp.concatenate([jnp.concatenate([zk, vb[:, :, :-1]], axis=2), vb], axis=3)
    s = jnp.einsum('brnqhd,brnkhd->brnhqk', qb, k2,
                   preferred_element_type=jnp.float32) * (HEAD_DIM ** -0.5)
    qi = jnp.arange(band)[:, None] + band
    ki = jnp.arange(2 * band)[None, :]
    dist = qi - ki
    local = (dist >= 0) & (dist <= band)
    kvalid = (jnp.arange(nb)[:, None] * band - band + ki) >= 0
    mask = local[None, :, :] & kvalid[:, None, :]
    s = jnp.where(mask[None, None, :, None], s, -jnp.inf)
    lse = jax.nn.logsumexp(s, axis=-1, keepdims=True)
    p = jnp.exp(s - lse)
    o = jnp.einsum('brnhqk,brnkhd->brnqhd', p, v2.astype(jnp.float32))
    o = o.reshape(b, r, lp, h, dh)[:, :, :l]
    lse = lse[..., 0].transpose(0, 1, 2, 4, 3).reshape(b, r, lp, h)[:, :, :l]
    return o, lse


def dilated_group_attention(q, k, v, window, dilation):
    b, s, h, dh = q.shape
    l = s // dilation

    def to_res(t):
        return t.reshape(b, l, dilation, h, dh).transpose(0, 2, 1, 3, 4)

    o, lse = banded_causal_attention(to_res(q), to_res(k), to_res(v), window // dilation)
    o = o.transpose(0, 2, 1, 3, 4).reshape(b, s, h, dh)
    lse = lse.transpose(0, 2, 1, 3).reshape(b, s, h)
    return o, lse


def even_mixer(h, w_in, conv_k, conv_b, ln_g, ln_b, w_out, cos, sin):
    b, s, _ = h.shape
    z = h @ w_in
    a_lin, a_gate, qkv = jnp.split(z, [CONV_CH, 2 * CONV_CH], axis=-1)
    a = a_lin * jax.nn.sigmoid(a_gate)
    a = causal_depthwise_conv(a, conv_k) + conv_b.astype(a.dtype)
    a = jax.nn.silu(layer_norm(a, ln_g, ln_b))
    q, k, v = jnp.split(qkv, 3, axis=-1)
    q = apply_rope(q.reshape(b, s, ATTN_HEADS, HEAD_DIM), cos, sin)
    k = apply_rope(k.reshape(b, s, ATTN_HEADS, HEAD_DIM), cos, sin)
    v = v.reshape(b, s, ATTN_HEADS, HEAD_DIM)
    outs, lses = [], []
    for g, (window, dilation) in enumerate(DILATED_PAIRS):
        sl = slice(g * HEADS_PER_GROUP, (g + 1) * HEADS_PER_GROUP)
        o, lse = dilated_group_attention(q[:, :, sl], k[:, :, sl], v[:, :, sl], window, dilation)
        outs.append(o)
        lses.append(lse)
    wts = jax.nn.softmax(jnp.stack(lses, axis=0), axis=0)
    att = jnp.sum(wts[..., None] * jnp.stack(outs, axis=0), axis=0)
    att = att.reshape(b, s, ATTN_OUT).astype(a.dtype)
    return jnp.concatenate([a, att], axis=-1) @ w_out


def odd_mixer(h, w_in, sconv_k, sg_ln_g, sg_ln_b, sg_w, sg_b, w_out):
    b, s, _ = h.shape
    z = h @ w_in
    gb, gc, xs, uv = jnp.split(z, [SCONV_CH, 2 * SCONV_CH, 3 * SCONV_CH], axis=-1)
    c_out = gb * causal_depthwise_conv(gc * xs, sconv_k)
    u, v = jnp.split(jax.nn.gelu(uv), 2, axis=-1)
    v = layer_norm(v, sg_ln_g, sg_ln_b)
    v = v.reshape(b, s // CHUNK, CHUNK, SG_GROUPS, SG_HEAD)
    ws = sg_w * jnp.tril(jnp.ones((CHUNK, CHUNK), dtype=sg_w.dtype))[None]
    v = jnp.einsum('gts,bnsgc->bntgc', ws.astype(v.dtype), v) + sg_b.T.astype(v.dtype)[None, None, :, :, None]
    d_out = u * v.reshape(b, s, SG_CH)
    return jnp.concatenate([c_out, d_out], axis=-1) @ w_out


def channel_mixer(h, w1, w2):
    return jnp.square(jax.nn.relu(h @ w1)) @ w2


def setup_inputs(seed: int = 0) -> dict:
    key = jax.random.key(seed)
    ks = jax.random.split(key, 20)
    f32 = jnp.float32

    def nrm(k, shape, scale):
        return jax.random.normal(k, shape, f32) * scale

    return {
        "x": nrm(ks[0], (BATCH, SEQ, D_MODEL), 1.0),
        "norm_mix_g": 1.0 + nrm(ks[1], (DEPTH, D_MODEL), 0.02),
        "norm_ffn_g": 1.0 + nrm(ks[2], (DEPTH, D_MODEL), 0.02),
        "even_w_in": nrm(ks[3], (N_EVEN, D_MODEL, EVEN_IN), D_MODEL ** -0.5),
        "even_conv_k": nrm(ks[4], (N_EVEN, CONV_WIDTH, CONV_CH), CONV_WIDTH ** -0.5),
        "even_conv_b": nrm(ks[5], (N_EVEN, CONV_CH), 0.02),
        "even_ln_g": 1.0 + nrm(ks[6], (N_EVEN, CONV_CH), 0.02),
        "even_ln_b": nrm(ks[7], (N_EVEN, CONV_CH), 0.02),
        "even_w_out": nrm(ks[8], (N_EVEN, EVEN_OUT, D_MODEL), EVEN_OUT ** -0.5),
        "odd_w_in": nrm(ks[9], (N_ODD, D_MODEL, ODD_IN), D_MODEL ** -0.5),
        "odd_conv_k": nrm(ks[10], (N_ODD, SCONV_WIDTH, SCONV_CH), SCONV_WIDTH ** -0.5),
        "odd_ln_g": 1.0 + nrm(ks[11], (N_ODD, SG_CH), 0.02),
        "odd_ln_b": nrm(ks[12], (N_ODD, SG_CH), 0.02),
        "odd_sg_w": nrm(ks[13], (N_ODD, SG_GROUPS, CHUNK, CHUNK), CHUNK ** -0.5),
        "odd_sg_b": 1.0 + nrm(ks[14], (N_ODD, SG_GROUPS, CHUNK), 0.02),
        "odd_w_out": nrm(ks[15], (N_ODD, ODD_OUT, D_MODEL), ODD_OUT ** -0.5),
        "ffn_w1": nrm(ks[16], (DEPTH, D_MODEL, D_FF), D_MODEL ** -0.5),
        "ffn_w2": nrm(ks[17], (DEPTH, D_FF, D_MODEL), D_FF ** -0.5),
        "final_g": 1.0 + nrm(ks[18], (D_MODEL,), 0.02),
    }


def reference(x, norm_mix_g, norm_ffn_g, even_w_in, even_conv_k, even_conv_b, even_ln_g,
              even_ln_b, even_w_out, odd_w_in, odd_conv_k, odd_ln_g, odd_ln_b, odd_sg_w,
              odd_sg_b, odd_w_out, ffn_w1, ffn_w2, final_g):
    cos, sin = rope_tables(x.shape[1])
    h = x
    for i in range(DEPTH):
        hn = rms_norm(h, norm_mix_g[i])
        if i % 2 == 0:
            j = i // 2
            mix = even_mixer(hn, even_w_in[j], even_conv_k[j], even_conv_b[j], even_ln_g[j],
                             even_ln_b[j], even_w_out[j], cos, sin)
        else:
            j = i // 2
            mix = odd_mixer(hn, odd_w_in[j], odd_conv_k[j], odd_ln_g[j], odd_ln_b[j],
                            odd_sg_w[j], odd_sg_b[j], odd_w_out[j])
        h = h + mix.astype(h.dtype)
        h = h + channel_mixer(rms_norm(h, norm_ffn_g[i]), ffn_w1[i], ffn_w2[i]).astype(h.dtype)
    return rms_norm(h, final_g)
```

```cpp
#include <hip/hip_runtime.h>
#include <cstdint>
#include <cstdio>

#define D_MODEL 1024
#define BATCH 8
#define SEQ 2048
#define EVEN_IN 5632
#define ODD_IN 2560
#define D_FF 4096
#define EPSF 1e-6f

template <int MODE>
__global__ void __launch_bounds__(256) gemm_f32(const float* __restrict__ A, const float* __restrict__ W, float* C, const float* R, int K, int N) {
    __shared__ float As[16][68];
    __shared__ float Bs[16][68];
    const int tid = threadIdx.x, tx = tid & 15, ty = tid >> 4;
    const int row0 = blockIdx.y * 64, col0 = blockIdx.x * 64;
    float acc[4][4];
#pragma unroll
    for (int i = 0; i < 4; ++i)
#pragma unroll
        for (int j = 0; j < 4; ++j) acc[i][j] = 0.f;
    for (int k0 = 0; k0 < K; k0 += 16) {
        {
            const int r = tid >> 2, kk = (tid & 3) * 4;
            const float4 v = *(const float4*)(A + (size_t)(row0 + r) * K + k0 + kk);
            As[kk + 0][r] = v.x; As[kk + 1][r] = v.y; As[kk + 2][r] = v.z; As[kk + 3][r] = v.w;
            const int kr = tid >> 4, cc = (tid & 15) * 4;
            const float4 w = *(const float4*)(W + (size_t)(k0 + kr) * N + col0 + cc);
            *(float4*)&Bs[kr][cc] = w;
        }
        __syncthreads();
#pragma unroll
        for (int k = 0; k < 16; ++k) {
            const float4 a = *(const float4*)&As[k][ty * 4];
            const float4 b = *(const float4*)&Bs[k][tx * 4];
            const float av[4] = {a.x, a.y, a.z, a.w}, bv[4] = {b.x, b.y, b.z, b.w};
#pragma unroll
            for (int i = 0; i < 4; ++i)
#pragma unroll
                for (int j = 0; j < 4; ++j) acc[i][j] += av[i] * bv[j];
        }
        __syncthreads();
    }
#pragma unroll
    for (int i = 0; i < 4; ++i) {
        const size_t off = (size_t)(row0 + ty * 4 + i) * N + col0 + tx * 4;
        float4 o;
        float v[4];
#pragma unroll
        for (int j = 0; j < 4; ++j) {
            float x = acc[i][j];
            if (MODE == 2) { x = x > 0.f ? x : 0.f; x = x * x; }
            v[j] = x;
        }
        if (MODE == 1) { const float4 r = *(const float4*)(R + off); v[0] += r.x; v[1] += r.y; v[2] += r.z; v[3] += r.w; }
        o.x = v[0]; o.y = v[1]; o.z = v[2]; o.w = v[3];
        *(float4*)(C + off) = o;
    }
}

__device__ __forceinline__ float block_sum_512(float v, float* red) {
#pragma unroll
    for (int o = 32; o > 0; o >>= 1) v += __shfl_xor(v, o);
    __syncthreads();
    if ((threadIdx.x & 63) == 0) red[threadIdx.x >> 6] = v;
    __syncthreads();
    float s = 0.f;
#pragma unroll
    for (int i = 0; i < 8; ++i) s += red[i];
    return s;
}

__global__ void __launch_bounds__(512) rms_kernel(const float* in, const float* g, float* out) {
    __shared__ float red[8];
    const int row = blockIdx.x, t = threadIdx.x;
    const float a = in[(size_t)row * 1024 + t], b = in[(size_t)row * 1024 + 512 + t];
    const float ss = block_sum_512(a * a + b * b, red);
    const float r = rsqrtf(ss * (1.f / 1024.f) + EPSF);
    out[(size_t)row * 1024 + t] = a * r * g[t];
    out[(size_t)row * 1024 + 512 + t] = b * r * g[512 + t];
}

__global__ void rope_table_kernel(float* cs) {
    const int i = blockIdx.x * blockDim.x + threadIdx.x;
    if (i >= SEQ * 32) return;
    const int s = i / 32, f = i % 32;
    const float inv = powf(10000.0f, -(float)f / 32.0f);
    const float ang = (float)s * inv;
    cs[2 * i] = cosf(ang); cs[2 * i + 1] = sinf(ang);
}
__global__ void rope_apply_kernel(float* z, const float* cs) {
    const int i = blockIdx.x * blockDim.x + threadIdx.x;
    if (i >= SEQ * 48 * 32) return;
    const int f = i % 32, hh = (i / 32) % 48, s = i / (32 * 48);
    float* p = z + (size_t)s * EVEN_IN + 1024 + hh * 64;
    const float c = cs[2 * (s * 32 + f)], sn = cs[2 * (s * 32 + f) + 1];
    const float x1 = p[f], x2 = p[f + 32];
    p[f] = x1 * c - x2 * sn; p[f + 32] = x2 * c + x1 * sn;
}

__global__ void __launch_bounds__(512) convmod_kernel(const float* z, const float* ck, const float* cb, const float* lg, const float* lb, float* cat) {
    __shared__ float red[8];
    const int t = blockIdx.x, c = threadIdx.x;
    float acc = cb[c];
    for (int j = 0; j < 31; ++j) {
        const int tt = t - 30 + j;
        if (tt >= 0) {
            const float lin = z[(size_t)tt * EVEN_IN + c], gate = z[(size_t)tt * EVEN_IN + 512 + c];
            acc += ck[j * 512 + c] * (lin / (1.f + expf(-gate)));
        }
    }
    const float mean = block_sum_512(acc, red) * (1.f / 512.f);
    const float d = acc - mean;
    const float var = block_sum_512(d * d, red) * (1.f / 512.f);
    const float y = d * rsqrtf(var + EPSF) * lg[c] + lb[c];
    cat[(size_t)t * 1024 + c] = y / (1.f + expf(-y));
}

__global__ void __launch_bounds__(256) attn_naive_kernel(const float* z, float* og, float* lse) {
    const int wid = threadIdx.x >> 6, d = threadIdx.x & 63;
    const int item = blockIdx.x * 4 + wid;
    const int hh = item % 24, t = item / 24;
    const int g = hh / 8, h = hh % 8;
    const int dil = (g == 0) ? 1 : (g == 1 ? 4 : 16);
    const float qd = z[(size_t)t * EVEN_IN + 1024 + hh * 64 + d];
    float m = -INFINITY, l = 0.f, o = 0.f;
    for (int j = 0; j <= 128; ++j) {
        const int tk = t - j * dil;
        if (tk < 0) break;
        const float kd = z[(size_t)tk * EVEN_IN + 1024 + 1536 + hh * 64 + d];
        float p = qd * kd;
#pragma unroll
        for (int off = 32; off > 0; off >>= 1) p += __shfl_xor(p, off);
        const float s = p * 0.125f;
        const float mn = fmaxf(m, s);
        const float sc = expf(m - mn), e = expf(s - mn);
        const float vd = z[(size_t)tk * EVEN_IN + 1024 + 3072 + hh * 64 + d];
        l = l * sc + e; o = o * sc + e * vd; m = mn;
    }
    og[((size_t)g * SEQ + t) * 512 + h * 64 + d] = o / l;
    if (d == 0) lse[((size_t)g * SEQ + t) * 8 + h] = m + logf(l);
}
__global__ void merge_kernel(const float* og, const float* lse, float* cat) {
    const int i = blockIdx.x * blockDim.x + threadIdx.x;
    if (i >= SEQ * 512) return;
    const int t = i / 512, c = i % 512, h = c / 64;
    const float l0 = lse[((size_t)0 * SEQ + t) * 8 + h], l1 = lse[((size_t)1 * SEQ + t) * 8 + h], l2 = lse[((size_t)2 * SEQ + t) * 8 + h];
    const float mx = fmaxf(l0, fmaxf(l1, l2));
    const float e0 = expf(l0 - mx), e1 = expf(l1 - mx), e2 = expf(l2 - mx);
    const float inv = 1.f / (e0 + e1 + e2);
    cat[(size_t)t * 1024 + 512 + c] = (e0 * og[((size_t)0 * SEQ + t) * 512 + c] + e1 * og[((size_t)1 * SEQ + t) * 512 + c] + e2 * og[((size_t)2 * SEQ + t) * 512 + c]) * inv;
}

__device__ __forceinline__ float gelu_tanh(float x) { return 0.5f * x * (1.f + tanhf(0.7978845608028654f * (x + 0.044715f * x * x * x))); }

__global__ void __launch_bounds__(512) oddmix_kernel(const float* z, const float* sk, const float* lg, const float* lb, float* ubuf, float* vn, float* cat) {
    __shared__ float red[8];
    const int t = blockIdx.x, c = threadIdx.x;
    const float* zr = z + (size_t)t * ODD_IN;
    const float u = gelu_tanh(zr[1536 + c]), v = gelu_tanh(zr[2048 + c]);
    const float mean = block_sum_512(v, red) * (1.f / 512.f);
    const float d = v - mean;
    const float var = block_sum_512(d * d, red) * (1.f / 512.f);
    vn[(size_t)t * 512 + c] = d * rsqrtf(var + EPSF) * lg[c] + lb[c];
    ubuf[(size_t)t * 512 + c] = u;
    float acc = 0.f;
    for (int j = 0; j < 3; ++j) {
        const int tt = t - 2 + j;
        if (tt >= 0) { const float* zz = z + (size_t)tt * ODD_IN; acc += sk[j * 512 + c] * zz[512 + c] * zz[1024 + c]; }
    }
    cat[(size_t)t * 1024 + c] = zr[c] * acc;
}
__global__ void sgu_kernel(const float* ubuf, const float* vn, const float* sgw, const float* sgb, float* cat) {
    const int i = blockIdx.x * blockDim.x + threadIdx.x;
    if (i >= SEQ * 512) return;
    const int t = i / 512, ch = i % 512, g = ch / 128, n = t / 128, tt = t % 128;
    float acc = sgb[g * 128 + tt];
    const float* w = sgw + ((size_t)g * 128 + tt) * 128;
    for (int ss = 0; ss <= tt; ++ss) acc += w[ss] * vn[(size_t)(n * 128 + ss) * 512 + ch];
    cat[(size_t)t * 1024 + 512 + ch] = ubuf[i] * acc;
}

extern "C" void kernel_launch(void* const* d_in, const int* in_sizes, int n_in, void* d_out, int out_size, void* d_ws, size_t ws_size, hipStream_t stream) {
    const float* x = (const float*)d_in[0];
    const float* norm_mix_g = (const float*)d_in[1];
    const float* norm_ffn_g = (const float*)d_in[2];
    const float* even_w_in = (const float*)d_in[3];
    const float* even_conv_k = (const float*)d_in[4];
    const float* even_conv_b = (const float*)d_in[5];
    const float* even_ln_g = (const float*)d_in[6];
    const float* even_ln_b = (const float*)d_in[7];
    const float* even_w_out = (const float*)d_in[8];
    const float* odd_w_in = (const float*)d_in[9];
    const float* odd_conv_k = (const float*)d_in[10];
    const float* odd_ln_g = (const float*)d_in[11];
    const float* odd_ln_b = (const float*)d_in[12];
    const float* odd_sg_w = (const float*)d_in[13];
    const float* odd_sg_b = (const float*)d_in[14];
    const float* odd_w_out = (const float*)d_in[15];
    const float* ffn_w1 = (const float*)d_in[16];
    const float* ffn_w2 = (const float*)d_in[17];
    const float* final_g = (const float*)d_in[18];
    float* out = (float*)d_out;
    float* ws = (float*)d_ws;
    float* cs = ws;                          ws += SEQ * 64;
    float* hn = ws;                          ws += SEQ * 1024;
    float* z = ws;                           ws += (size_t)SEQ * EVEN_IN;
    float* cat = ws;                         ws += SEQ * 1024;
    float* og = ws;                          ws += 3 * SEQ * 512;
    float* lse = ws;                         ws += 3 * SEQ * 8;
    float* u = ws;                           ws += (size_t)SEQ * D_FF;
    float* ubuf = ws;                        ws += SEQ * 512;
    float* vn = ws;                          ws += SEQ * 512;

    rope_table_kernel<<<(SEQ * 32 + 255) / 256, 256, 0, stream>>>(cs);
    for (int b = 0; b < BATCH; ++b) {
        const float* xb = x + (size_t)b * SEQ * 1024;
        float* hb = out + (size_t)b * SEQ * 1024;
        rms_kernel<<<SEQ, 512, 0, stream>>>(xb, norm_mix_g, hn);
        gemm_f32<0><<<dim3(EVEN_IN / 64, SEQ / 64), 256, 0, stream>>>(hn, even_w_in, z, nullptr, 1024, EVEN_IN);
        rope_apply_kernel<<<(SEQ * 48 * 32 + 255) / 256, 256, 0, stream>>>(z, cs);
        convmod_kernel<<<SEQ, 512, 0, stream>>>(z, even_conv_k, even_conv_b, even_ln_g, even_ln_b, cat);
        attn_naive_kernel<<<SEQ * 24 / 4, 256, 0, stream>>>(z, og, lse);
        merge_kernel<<<(SEQ * 512 + 255) / 256, 256, 0, stream>>>(og, lse, cat);
        gemm_f32<1><<<dim3(1024 / 64, SEQ / 64), 256, 0, stream>>>(cat, even_w_out, hb, xb, 1024, 1024);
        rms_kernel<<<SEQ, 512, 0, stream>>>(hb, norm_ffn_g, hn);
        gemm_f32<2><<<dim3(D_FF / 64, SEQ / 64), 256, 0, stream>>>(hn, ffn_w1, u, nullptr, 1024, D_FF);
        gemm_f32<1><<<dim3(1024 / 64, SEQ / 64), 256, 0, stream>>>(u, ffn_w2, hb, hb, D_FF, 1024);
        rms_kernel<<<SEQ, 512, 0, stream>>>(hb, norm_mix_g + 1024, hn);
        gemm_f32<0><<<dim3(ODD_IN / 64, SEQ / 64), 256, 0, stream>>>(hn, odd_w_in, z, nullptr, 1024, ODD_IN);
        oddmix_kernel<<<SEQ, 512, 0, stream>>>(z, odd_conv_k, odd_ln_g, odd_ln_b, ubuf, vn, cat);
        sgu_kernel<<<(SEQ * 512 + 255) / 256, 256, 0, stream>>>(ubuf, vn, odd_sg_w, odd_sg_b, cat);
        gemm_f32<1><<<dim3(1024 / 64, SEQ / 64), 256, 0, stream>>>(cat, odd_w_out, hb, hb, 1024, 1024);
        rms_kernel<<<SEQ, 512, 0, stream>>>(hb, norm_ffn_g + 1024, hn);
        gemm_f32<2><<<dim3(D_FF / 64, SEQ / 64), 256, 0, stream>>>(hn, ffn_w1 + (size_t)1024 * D_FF, u, nullptr, 1024, D_FF);
        gemm_f32<1><<<dim3(1024 / 64, SEQ / 64), 256, 0, stream>>>(u, ffn_w2 + (size_t)D_FF * 1024, hb, hb, D_FF, 1024);
        rms_kernel<<<SEQ, 512, 0, stream>>>(hb, final_g, hb);
    }
}
```

```cpp
#include <hip/hip_runtime.h>
#include <hip/hip_cooperative_groups.h>
#include <cstdio>
#include <cstdint>
namespace cg = cooperative_groups;

#ifndef MK_CHECK
#define MK_CHECK 0
#endif

constexpr int M = 16384, DM = 1024, SEQ = 2048, NIN0 = 5632, NIN1 = 2560, FF = 4096;
constexpr float EPS = 1e-6f;
constexpr float QSCALE = 0.125f * 1.4426950408889634f;
constexpr size_t MiB = 1u << 20;
constexpr size_t WS_CTL = 0;
constexpr size_t WS_CS = 1 * MiB;
constexpr size_t WS_SS = WS_CS + 512 * 1024;
constexpr size_t WS_VST = WS_SS + 5 * M * 4;
constexpr size_t WS_LSE = 2 * MiB;
constexpr size_t WS_W = 4 * MiB;
constexpr size_t WS_WIN0 = WS_W, WS_WOUT0 = WS_WIN0 + 11 * MiB, WS_W1_0 = WS_WOUT0 + 2 * MiB, WS_W2_0 = WS_W1_0 + 8 * MiB;
constexpr size_t WS_WIN1 = WS_W2_0 + 8 * MiB, WS_WOUT1 = WS_WIN1 + 5 * MiB, WS_W1_1 = WS_WOUT1 + 2 * MiB, WS_W2_1 = WS_W1_1 + 8 * MiB;
constexpr size_t WS_R1 = 56 * MiB;
constexpr size_t WS_GLU = 88 * MiB;
constexpr size_t WS_H1B = 88 * MiB;
constexpr size_t WS_QK = 104 * MiB;
constexpr size_t WS_V = 200 * MiB;
constexpr size_t WS_U = 120 * MiB;
constexpr size_t WS_GB = 88 * MiB, WS_G = 104 * MiB, WS_UB = 120 * MiB, WS_VT = 136 * MiB, WS_MIX1 = 152 * MiB;
constexpr size_t WS_END = 248 * MiB;
static_assert(WS_W2_1 + 8 * MiB == WS_R1, "weights end at R1");
constexpr int LDS_BYTES = 147456;

namespace pg8 {
#define PG8_LAS __attribute__((address_space(3)))
typedef unsigned short bf16_t;
typedef short bf16x8 __attribute__((ext_vector_type(8)));
typedef float f32x4 __attribute__((ext_vector_type(4)));
typedef unsigned u32x4 __attribute__((ext_vector_type(4)));
constexpr int BM = 256, BK = 64, HALF = 128, HTB = HALF * BK * 2  , STAGE_BYTES = 8 * HTB, NXCD = 8, WGM = 8;

__host__ __device__ __forceinline__ int lds_byte(int r, int c) { const int st = (r >> 4) * 2 + (c >> 5), rr = r & 15, cc = c & 31, ob = rr * 64 + cc * 2; return st * 1024 + (ob ^ (((ob >> 9) & 1) << 5)); }
__host__ __device__ __forceinline__ void stage_rc(int b, int& R, int& C) { const int st = b / 1024, sb = b % 1024, swz = sb ^ (((sb >> 9) & 1) << 5); R = (st >> 1) * 16 + swz / 64; C = (st & 1) * 32 + (swz % 64) / 2; }
__host__ __device__ __forceinline__ int perm32(int rho) { const int n = rho >> 4, i = rho & 15; return 8 * (i >> 2) + 4 * n + (i & 3); }

struct Unit { int pm, pn; };
struct Gemm { const bf16_t* A; const bf16_t* Bt; int M, N, K; };

struct StaticOrder {
    int nM, nN, nwg, G, c;
    __host__ __device__ void init(int M, int N, int G_, int c_) { nM = M / BM; nN = N / BM; nwg = nM * nN; G = G_; c = c_; }
    __host__ __device__ bool next(int i, Unit& u) const {
        const long L = (long)i * G + c; if (L >= nwg) return false;
        int wgid = (int)L; { const int q = nwg / NXCD, r = nwg % NXCD, xcd = wgid % NXCD, off = wgid / NXCD; wgid = (xcd < r ? xcd * (q + 1) : r * (q + 1) + (xcd - r) * q) + off; }
        const int nig = WGM * nN, gid = wgid / nig, fm = gid * WGM, gsz = (nM - fm) < WGM ? (nM - fm) : WGM;
        u.pm = fm + ((wgid % nig) % gsz); u.pn = (wgid % nig) / gsz; return true;
    }
    __device__ __forceinline__ void a_ready(const Unit&) const {}
    __device__ __forceinline__ void done(const Unit&) const {}
};

__device__ __forceinline__ unsigned cvt_pk_bf16(float lo, float hi) { unsigned r; asm volatile("v_cvt_pk_bf16_f32 %0, %1, %2" : "=v"(r) : "v"(lo), "v"(hi)); return r; }
typedef float f32x2 __attribute__((ext_vector_type(2)));
typedef unsigned u32x2 __attribute__((ext_vector_type(2)));
__device__ __forceinline__ void store8(bf16_t* p, const f32x4& a, const f32x4& b) { u32x4 w; w.x = cvt_pk_bf16(a[0], a[1]); w.y = cvt_pk_bf16(a[2], a[3]); w.z = cvt_pk_bf16(b[0], b[1]); w.w = cvt_pk_bf16(b[2], b[3]); *(u32x4*)p = w; }
__device__ __forceinline__ void store4(bf16_t* p, const f32x4& a) { u32x2 w; w.x = cvt_pk_bf16(a[0], a[1]); w.y = cvt_pk_bf16(a[2], a[3]); *(u32x2*)p = w; }
__device__ __forceinline__ float sigm(float x) { return __builtin_amdgcn_rcpf(1.f + __expf(-x)); }
__device__ __forceinline__ float gelu_t(float x) { const float t = 1.5957691216057308f * (x + 0.044715f * x * x * x); return x * sigm(t); }
struct EpiP {
    const float* ss; float* ss_out; const float* resid; float* hout; bf16_t* hb;
    bf16_t* o0; bf16_t* o1; bf16_t* o2; bf16_t* o3; const float* cs; float* vst;
};
template <int KIND> struct Epi {
    static constexpr bool PERM = true, AFTER_DRAIN = false;
    EpiP p;
    __device__ __forceinline__ void operator()(const f32x4 (&acc)[2][2][4][2], const Unit& u, int wr, int wc, int fr, int fq) const {
        const int colt = u.pn * BM + wc * 32 + 8 * fq;
#pragma unroll
        for (int ai = 0; ai < 2; ++ai)
#pragma unroll
            for (int m = 0; m < 4; ++m) {
                const int row = u.pm * BM + ai * HALF + wr * 64 + m * 16 + fr;
                float r = 1.f;
                if (KIND != 1) r = rsqrtf(p.ss[row] * (1.f / 1024.f) + 1e-6f);
                float sq = 0.f, s1 = 0.f;
#pragma unroll
                for (int bj = 0; bj < 2; ++bj) {
                    const int c0 = colt + bj * HALF;
                    f32x4 v0 = acc[ai][bj][m][0] * r, v1 = acc[ai][bj][m][1] * r;
                    if (KIND == 0) {
                        if (u.pn < 4) {
                            f32x4 o;
#pragma unroll
                            for (int j = 0; j < 4; ++j) o[j] = v0[j] * sigm(v1[j]);
                            store4(p.o0 + (size_t)row * 512 + (c0 >> 1), o);
                        } else if (u.pn < 16) {
                            const int qq = ((c0 - 1024) & 63) >> 3, pos = row & 2047;
                            const f32x4* t = (const f32x4*)(p.cs + ((size_t)pos * 32 + 4 * qq) * 2);
                            const f32x4 t0 = t[0], t1 = t[1];
                            const f32x4 cc = {t0[0], t0[2], t1[0], t1[2]}, sn = {t0[1], t0[3], t1[1], t1[3]};
                            f32x4 o1 = v0 * cc - v1 * sn, o2 = v1 * cc + v0 * sn;
                            if (u.pn < 10) { o1 = o1 * QSCALE; o2 = o2 * QSCALE; }
                            store8(p.o1 + (size_t)row * 3072 + (c0 - 1024), o1, o2);
                        } else {
                            store8(p.o2 + (size_t)row * 1536 + (c0 - 4096), v0, v1);
                        }
                    } else if (KIND == 1) {
                        const size_t off = (size_t)row * 1024 + c0;
                        const f32x4 r0 = *(const f32x4*)(p.resid + off), r1 = *(const f32x4*)(p.resid + off + 4);
                        v0 = v0 + r0; v1 = v1 + r1;
                        *(f32x4*)(p.hout + off) = v0; *(f32x4*)(p.hout + off + 4) = v1;
                        if (p.hb) store8(p.hb + off, v0, v1);
#pragma unroll
                        for (int j = 0; j < 4; ++j) sq += v0[j] * v0[j] + v1[j] * v1[j];
                    } else if (KIND == 2) {
#pragma unroll
                        for (int j = 0; j < 4; ++j) { float a = fmaxf(v0[j], 0.f), b = fmaxf(v1[j], 0.f); v0[j] = a * a; v1[j] = b * b; }
                        store8(p.o0 + (size_t)row * 4096 + c0, v0, v1);
                    } else {
                        if (u.pn < 2) store8(p.o0 + (size_t)row * 512 + c0, v0, v1);
                        else if (u.pn < 6) { const f32x4 o = v0 * v1; store4(p.o1 + (size_t)row * 512 + ((c0 - 512) >> 1), o); }
                        else if (u.pn < 8) {
#pragma unroll
                            for (int j = 0; j < 4; ++j) { v0[j] = gelu_t(v0[j]); v1[j] = gelu_t(v1[j]); }
                            store8(p.o2 + (size_t)row * 512 + (c0 - 1536), v0, v1);
                        } else {
                            bf16_t* vt = p.o3 + (size_t)(c0 - 2048) * ::M + row;
#pragma unroll
                            for (int j = 0; j < 4; ++j) { v0[j] = gelu_t(v0[j]); v1[j] = gelu_t(v1[j]); s1 += v0[j] + v1[j]; sq += v0[j] * v0[j] + v1[j] * v1[j]; }
#pragma unroll
                            for (int j = 0; j < 4; ++j) { vt[(size_t)j * ::M] = (bf16_t)(cvt_pk_bf16(v0[j], 0.f) & 0xffffu); vt[(size_t)(j + 4) * ::M] = (bf16_t)(cvt_pk_bf16(v1[j], 0.f) & 0xffffu); }
                        }
                    }
                }
                if (KIND == 1) {
                    sq += __shfl_xor(sq, 16); sq += __shfl_xor(sq, 32);
                    if (fq == 0) atomicAdd(p.ss_out + row, sq);
                }
                if (KIND == 3) {
                    if (u.pn >= 8) {
                        sq += __shfl_xor(sq, 16); sq += __shfl_xor(sq, 32); s1 += __shfl_xor(s1, 16); s1 += __shfl_xor(s1, 32);
                        if (fq == 0) { atomicAdd(p.vst + 2 * row, s1); atomicAdd(p.vst + 2 * row + 1, sq); }
                    }
                }
            }
    }
};
template <class Epi, class Sched, bool ALIGN_EPI = false, bool SP2 = false>
__device__ __forceinline__ void gemm_phase(PG8_LAS unsigned char* lds, const Gemm g, const Sched& S, const Epi& E) {
    const int tid = threadIdx.x, wid = __builtin_amdgcn_readfirstlane(tid >> 6), lane = tid & 63, wr = wid >> 2, wc = wid & 3, fr = lane & 15, fq = lane >> 4;
    const int K = g.K, nt = K / BK;
    unsigned voffA[2], voffB[2];
#pragma unroll
    for (int i = 0; i < 2; ++i) { int R, C; stage_rc(tid * 16 + i * 8192, R, C); const int Rb = Epi::PERM ? ((R & ~31) + perm32(R & 31)) : R;
        voffA[i] = (unsigned)(R * K + C) * 2u; voffB[i] = (unsigned)(Rb * K + C) * 2u; }
    const size_t kstep = (size_t)(BK * 2);
    const size_t hstep = (size_t)HALF * K * 2;
    const size_t tstep = 2 * hstep;
    const unsigned ldsw = (unsigned)wid * 1024u;
    const int aoff = lds_byte(wr * 64 + fr, fq * 8), boff = lds_byte(wc * 32 + fr, fq * 8);
#define PG8_SA(b, h) (((b) * 2 + (h)) * HTB)
#define PG8_SB(b, h) ((4 + (b) * 2 + (h)) * HTB)
#define PG8_STAGE(bufoff, gbase, voff) do { _Pragma("unroll") for (int _i = 0; _i < 2; ++_i) \
        __builtin_amdgcn_global_load_lds((const unsigned*)((const char*)(gbase) + (voff)[_i]), (PG8_LAS unsigned*)(lds + (bufoff) + ldsw + _i * 8192), 16, 0, 0); } while (0)
#define PG8_LDA(dst, b, h) do { _Pragma("unroll") for (int m = 0; m < 4; ++m) _Pragma("unroll") for (int k = 0; k < 2; ++k) dst[m][k] = *(const PG8_LAS bf16x8*)(lds + PG8_SA(b, h) + aoff + m * 2048 + k * 1024); } while (0)
#define PG8_LDB(dst, b, h) do { _Pragma("unroll") for (int n = 0; n < 2; ++n) _Pragma("unroll") for (int k = 0; k < 2; ++k) dst[n][k] = *(const PG8_LAS bf16x8*)(lds + PG8_SB(b, h) + boff + n * 2048 + k * 1024); } while (0)
#define PG8_MMA(ai, bj, At, Bt) do { __builtin_amdgcn_s_setprio(1); _Pragma("unroll") for (int m = 0; m < 4; ++m) _Pragma("unroll") for (int n = 0; n < 2; ++n) _Pragma("unroll") for (int k = 0; k < 2; ++k) \
        acc[ai][bj][m][n] = __builtin_amdgcn_mfma_f32_16x16x32_bf16(Bt[n][k], At[m][k], acc[ai][bj][m][n], 0, 0, 0); __builtin_amdgcn_s_setprio(0); } while (0)
#define PG8_WAIT_V(n) asm volatile("s_waitcnt vmcnt(" #n ")" ::: "memory")
#define PG8_WAIT_L(n) asm volatile("s_waitcnt lgkmcnt(" #n ")" ::: "memory")
#define PG8_BAR __builtin_amdgcn_s_barrier()
#define PG8_SCHED __builtin_amdgcn_sched_barrier(0)
    Unit cur, nxt; int ui = 0;
    if (!S.next(0, cur)) return;
    f32x4 acc[2][2][4][2];
#pragma unroll
    for (int a = 0; a < 2; ++a)
#pragma unroll
        for (int b = 0; b < 2; ++b)
#pragma unroll
            for (int m = 0; m < 4; ++m)
#pragma unroll
                for (int n = 0; n < 2; ++n) acc[a][b][m][n] = (f32x4){0.f, 0.f, 0.f, 0.f};
    bf16x8 At[4][2], B0[2][2], B1[2][2];
    const char* cA = (const char*)g.A + (size_t)cur.pm * tstep; const char* cB = (const char*)g.Bt + (size_t)cur.pn * tstep;
    S.a_ready(cur);
    if constexpr (SP2) {
        PG8_STAGE(PG8_SB(0, 0), cB, voffB); PG8_STAGE(PG8_SB(0, 1), cB + hstep, voffB); PG8_STAGE(PG8_SA(0, 0), cA, voffA); PG8_STAGE(PG8_SA(0, 1), cA + hstep, voffA);
        if (wr == 1) PG8_BAR;
        PG8_WAIT_V(2); PG8_BAR;
        PG8_STAGE(PG8_SB(1, 0), cB + kstep, voffB); PG8_STAGE(PG8_SA(1, 0), cA + kstep, voffA); PG8_STAGE(PG8_SB(1, 1), cB + hstep + kstep, voffB);
        PG8_WAIT_V(6); PG8_BAR;
    } else {
        PG8_STAGE(PG8_SB(0, 0), cB, voffB); PG8_STAGE(PG8_SA(0, 0), cA, voffA); PG8_STAGE(PG8_SB(0, 1), cB + hstep, voffB); PG8_STAGE(PG8_SA(0, 1), cA + hstep, voffA);
        if (wr == 1) PG8_BAR;
        PG8_WAIT_V(4); PG8_BAR;
        PG8_STAGE(PG8_SB(1, 0), cB + kstep, voffB); PG8_STAGE(PG8_SA(1, 0), cA + kstep, voffA); PG8_STAGE(PG8_SB(1, 1), cB + hstep + kstep, voffB);
        PG8_WAIT_V(6); PG8_BAR;
    }
    for (;;) {
        const bool has_next = S.next(ui + 1, nxt);
        const char* nA = has_next ? (const char*)g.A + (size_t)nxt.pm * tstep : cA; const char* nB = has_next ? (const char*)g.Bt + (size_t)nxt.pn * tstep : cB;
        for (int t = 0; t < nt; t += 2) {
            const bool last = (t == nt - 2);
            const char* a1 = cA + (size_t)(t + 1) * kstep;
            const char* a2 = last ? nA : cA + (size_t)(t + 2) * kstep; const char* b2 = last ? nB : cB + (size_t)(t + 2) * kstep;
            const char* a3 = a2 + kstep; const char* b3 = b2 + kstep;
            if (last && has_next) S.a_ready(nxt);
            if constexpr (SP2) {
            PG8_LDB(B0, 0, 0); PG8_LDB(B1, 0, 1); PG8_SCHED; PG8_LDA(At, 0, 0); PG8_STAGE(PG8_SA(1, 1), a1 + hstep, voffA);
            PG8_WAIT_V(8); PG8_WAIT_L(0); PG8_BAR; PG8_MMA(0, 0, At, B0); PG8_MMA(0, 1, At, B1); PG8_BAR; PG8_SCHED;
            PG8_LDA(At, 0, 1); PG8_STAGE(PG8_SB(0, 0), b2, voffB); PG8_STAGE(PG8_SB(0, 1), b2 + hstep, voffB); PG8_STAGE(PG8_SA(0, 0), a2, voffA);
            PG8_WAIT_V(8); PG8_WAIT_L(0); PG8_BAR; PG8_MMA(1, 0, At, B0); PG8_MMA(1, 1, At, B1); PG8_BAR; PG8_SCHED;
            PG8_LDB(B0, 1, 0); PG8_LDB(B1, 1, 1); PG8_SCHED; PG8_LDA(At, 1, 0); PG8_STAGE(PG8_SA(0, 1), a2 + hstep, voffA);
            PG8_WAIT_V(8); PG8_WAIT_L(0); PG8_BAR; PG8_MMA(0, 0, At, B0); PG8_MMA(0, 1, At, B1); PG8_BAR; PG8_SCHED;
            PG8_LDA(At, 1, 1); PG8_STAGE(PG8_SB(1, 0), b3, voffB); PG8_STAGE(PG8_SB(1, 1), b3 + hstep, voffB); PG8_STAGE(PG8_SA(1, 0), a3, voffA);
            PG8_WAIT_V(8); PG8_WAIT_L(0); PG8_BAR; PG8_MMA(1, 0, At, B0); PG8_MMA(1, 1, At, B1); PG8_BAR; PG8_SCHED;
            } else {
            PG8_LDB(B0, 0, 0); PG8_SCHED; PG8_LDA(At, 0, 0); PG8_STAGE(PG8_SA(1, 1), a1 + hstep, voffA);
            PG8_WAIT_L(8); PG8_BAR; PG8_WAIT_L(0); PG8_MMA(0, 0, At, B0); PG8_BAR; PG8_SCHED;
            PG8_LDB(B1, 0, 1); PG8_STAGE(PG8_SB(0, 0), b2, voffB);
            PG8_BAR; PG8_WAIT_L(0); PG8_MMA(0, 1, At, B1); PG8_BAR;
            PG8_LDA(At, 0, 1); PG8_STAGE(PG8_SA(0, 0), a2, voffA);
            PG8_BAR; PG8_WAIT_L(0); PG8_MMA(1, 0, At, B0); PG8_BAR; PG8_SCHED;
            PG8_STAGE(PG8_SB(0, 1), b2 + hstep, voffB);
            PG8_WAIT_V(6); PG8_BAR; PG8_MMA(1, 1, At, B1); PG8_BAR;
            PG8_LDB(B0, 1, 0); PG8_SCHED; PG8_LDA(At, 1, 0); PG8_STAGE(PG8_SA(0, 1), a2 + hstep, voffA);
            PG8_WAIT_L(8); PG8_BAR; PG8_WAIT_L(0); PG8_MMA(0, 0, At, B0); PG8_BAR; PG8_SCHED;
            PG8_LDB(B1, 1, 1); PG8_STAGE(PG8_SB(1, 0), b3, voffB);
            PG8_BAR; PG8_WAIT_L(0); PG8_MMA(0, 1, At, B1); PG8_BAR;
            PG8_LDA(At, 1, 1); PG8_STAGE(PG8_SA(1, 0), a3, voffA);
            PG8_BAR; PG8_WAIT_L(0); PG8_MMA(1, 0, At, B0); PG8_BAR; PG8_SCHED;
            PG8_STAGE(PG8_SB(1, 1), b3 + hstep, voffB);
            PG8_WAIT_V(6); PG8_BAR; PG8_MMA(1, 1, At, B1); PG8_BAR;
            }
        }
        if constexpr (ALIGN_EPI) { if (wr == 0) PG8_BAR; }
        if constexpr (!Epi::AFTER_DRAIN) { E(acc, cur, wr, wc, fr, fq); S.done(cur); }
        if (!has_next) break;
#pragma unroll
        for (int a = 0; a < 2; ++a)
#pragma unroll
            for (int b = 0; b < 2; ++b)
#pragma unroll
                for (int m = 0; m < 4; ++m)
#pragma unroll
                    for (int n = 0; n < 2; ++n) acc[a][b][m][n] = (f32x4){0.f, 0.f, 0.f, 0.f};
        cur = nxt; cA = nA; cB = nB; ++ui;
        if constexpr (ALIGN_EPI) { if (wr == 1) PG8_BAR; }
    }
    PG8_WAIT_V(0);
    if constexpr (!ALIGN_EPI) { if (wr == 0) PG8_BAR; }
    PG8_BAR;
    if constexpr (Epi::AFTER_DRAIN) { E.fused(acc, cur, wr, wc, fr, fq, lds, wid, lane); S.done(cur); }
#undef PG8_SA
#undef PG8_SB
#undef PG8_STAGE
#undef PG8_LDA
#undef PG8_LDB
#undef PG8_MMA
#undef PG8_WAIT_V
#undef PG8_WAIT_L
#undef PG8_BAR
#undef PG8_SCHED
}
}
#define LAS __attribute__((address_space(3)))
typedef unsigned short bf16_t;
typedef short bf16x8 __attribute__((ext_vector_type(8)));
typedef short s16x4 __attribute__((ext_vector_type(4)));
typedef float f32x4 __attribute__((ext_vector_type(4)));
typedef float f32x16 __attribute__((ext_vector_type(16)));
typedef unsigned u32x4 __attribute__((ext_vector_type(4)));
typedef float f32x2_t __attribute__((ext_vector_type(2)));
typedef __bf16 bf16x2_t __attribute__((ext_vector_type(2)));
__device__ __forceinline__ unsigned pk2(float lo, float hi) { f32x2_t v = {lo, hi}; bf16x2_t b = __builtin_convertvector(v, bf16x2_t); return __builtin_bit_cast(unsigned, b); }
__device__ __forceinline__ float bf2f(unsigned short x) { return __uint_as_float((unsigned)x << 16); }
__device__ __forceinline__ float bflo(unsigned w) { return __uint_as_float(w << 16); }
__device__ __forceinline__ float bfhi(unsigned w) { return __uint_as_float(w & 0xffff0000u); }
__device__ __forceinline__ int crow(int r, int hi) { return (r & 3) + 8 * (r >> 2) + 4 * hi; }
__device__ __forceinline__ float wave_sum(float v) {
#pragma unroll
    for (int o = 1; o < 64; o <<= 1) v += __shfl_xor(v, o);
    return v;
}

struct Args { const float* in[19]; float* out; unsigned char* ws; };

__device__ __forceinline__ int perm_in0(int n) {
    if (n < 1024) { const int q8 = n >> 3, e = n & 7; return (e < 4) ? (4 * q8 + e) : (512 + 4 * q8 + (e - 4)); }
    if (n < 4096) { const int w = (n - 1024) & 63, hh = (n - 1024) >> 6, qq = w >> 3, e = w & 7; return 1024 + 64 * hh + 4 * qq + (e & 3) + ((e >= 4) ? 32 : 0); }
    return n;
}
__device__ __forceinline__ int perm_in1(int n) {
    if (n >= 512 && n < 1536) { const int mm = n - 512, q8 = mm >> 3, e = mm & 7; return (e < 4) ? (512 + 4 * q8 + e) : (1024 + 4 * q8 + (e - 4)); }
    return n;
}
template <int PERM>
__device__ __forceinline__ void transpose_item(const float* W, int K, int N, const float* kscale, bf16_t* WT, LAS float* scr, int item, int lane) {
    const int nblk = N / 32, kb = item / nblk, nb = item % nblk, k0 = 64 * kb, n0 = 32 * nb;
    const int nd = n0 + (lane & 31);
    const int ns = (PERM == 1) ? perm_in0(nd) : (PERM == 2) ? perm_in1(nd) : nd;
#pragma unroll 8
    for (int i = 0; i < 32; ++i) { const int kk = 2 * i + (lane >> 5); float w = W[(size_t)(k0 + kk) * N + ns]; if (kscale) w *= kscale[k0 + kk]; scr[kk * 33 + (lane & 31)] = w; }
    asm volatile("s_waitcnt lgkmcnt(0)" ::: "memory");
    const int c = lane & 7;
#pragma unroll
    for (int j = 0; j < 4; ++j) { const int n = (lane >> 3) + 8 * j; const LAS float* s = scr + (8 * c) * 33 + n;
        u32x4 o; o.x = pk2(s[0 * 33], s[1 * 33]); o.y = pk2(s[2 * 33], s[3 * 33]); o.z = pk2(s[4 * 33], s[5 * 33]); o.w = pk2(s[6 * 33], s[7 * 33]);
        *(u32x4*)(WT + (size_t)(n0 + n) * K + k0 + 8 * c) = o; }
    asm volatile("s_waitcnt lgkmcnt(0)" ::: "memory");
}

__device__ __forceinline__ s16x4 vtr(const LAS unsigned char* p) { typedef short v4i16_t __attribute__((ext_vector_type(4))); return __builtin_bit_cast(s16x4, __builtin_amdgcn_ds_read_tr16_b64_v4i16((LAS v4i16_t*)p)); }
__device__ __forceinline__ void attn_wave_unit(bf16_t* QK, const bf16_t* Vb, float* lse2, int b, int g, int h, int r, int i0, LAS unsigned char* vl, int lane) {
    const int dil = (g == 0) ? 1 : (g == 1 ? 4 : 16);
    const int hh = g * 8 + h, ql = lane & 31, hi = lane >> 5;
    const size_t rowbase = (size_t)b * SEQ + r;
    const bf16_t* qp = QK + (rowbase + (size_t)(i0 + ql) * dil) * 3072 + hh * 64 + hi * 8;
    bf16x8 qf[4];
#pragma unroll
    for (int s = 0; s < 4; ++s) qf[s] = *(const bf16x8*)(qp + 16 * s);
    f32x16 S[5];
    const float NEG = -INFINITY;
#pragma unroll
    for (int j = 0; j < 5; ++j) {
        const int kb = i0 - 128 + 32 * j;
        if (kb >= 0) {
            const bf16_t* kp = QK + (rowbase + (size_t)(kb + ql) * dil) * 3072 + 1536 + hh * 64 + hi * 8;
            f32x16 acc = {};
#pragma unroll
            for (int s = 0; s < 4; ++s) { const bf16x8 kf = *(const bf16x8*)(kp + 16 * s); acc = __builtin_amdgcn_mfma_f32_32x32x16_bf16(kf, qf[s], acc, 0, 0, 0); }
            if (j == 0) {
#pragma unroll
                for (int rr = 0; rr < 16; ++rr) if (crow(rr, hi) < ql) acc[rr] = NEG;
            }
            if (j == 4) {
#pragma unroll
                for (int rr = 0; rr < 16; ++rr) if (crow(rr, hi) > ql) acc[rr] = NEG;
            }
            S[j] = acc;
        } else {
#pragma unroll
            for (int rr = 0; rr < 16; ++rr) S[j][rr] = NEG;
        }
    }
    float mx = NEG;
#pragma unroll
    for (int j = 0; j < 5; ++j)
#pragma unroll
        for (int rr = 0; rr < 16; ++rr) mx = fmaxf(mx, S[j][rr]);
    mx = fmaxf(mx, __shfl_xor(mx, 32));
    float l = 0.f;
#pragma unroll
    for (int j = 0; j < 5; ++j)
#pragma unroll
        for (int rr = 0; rr < 16; ++rr) { const float pe = __builtin_amdgcn_exp2f(S[j][rr] - mx); S[j][rr] = pe; l += pe; }
    l += __shfl_xor(l, 32);
    const float inv = 1.f / l;
    if (hi == 0) lse2[((size_t)g * M + rowbase + (size_t)(i0 + ql) * dil) * 8 + h] = mx + __builtin_amdgcn_logf(l);
    f32x16 O0 = {}, O1 = {};
    const int li = lane & 15, gq = li >> 2, gp = li & 3, chh = (lane >> 4) & 1;
#pragma unroll
    for (int j = 0; j < 5; ++j) {
        const int kb = i0 - 128 + 32 * j;
        if (kb >= 0) {
            asm volatile("" ::: "memory");
#pragma unroll
            for (int i = 0; i < 4; ++i) { const int rk = 8 * i + (lane >> 3), ch = lane & 7;
                const u32x4 v = *(const u32x4*)(Vb + (rowbase + (size_t)(kb + rk) * dil) * 1536 + hh * 64 + ch * 8);
                *(LAS u32x4*)(vl + rk * 128 + ch * 16) = v; }
            asm volatile("s_waitcnt lgkmcnt(0)" ::: "memory");
#pragma unroll
            for (int s = 0; s < 2; ++s) {
                u32x4 pw;
                pw.x = pk2(S[j][8 * s + 0] * inv, S[j][8 * s + 1] * inv); pw.y = pk2(S[j][8 * s + 2] * inv, S[j][8 * s + 3] * inv);
                pw.z = pk2(S[j][8 * s + 4] * inv, S[j][8 * s + 5] * inv); pw.w = pk2(S[j][8 * s + 6] * inv, S[j][8 * s + 7] * inv);
                const bf16x8 pa = __builtin_bit_cast(bf16x8, pw);
#pragma unroll
                for (int db = 0; db < 2; ++db) {
                    const LAS unsigned char* a1 = vl + (16 * s + 4 * hi + gq) * 128 + (32 * db + 16 * chh + 4 * gp) * 2;
                    const s16x4 lo = vtr(a1), hv = vtr(a1 + 8 * 128);
                    const bf16x8 vb = {lo[0], lo[1], lo[2], lo[3], hv[0], hv[1], hv[2], hv[3]};
                    if (db == 0) O0 = __builtin_amdgcn_mfma_f32_32x32x16_bf16(pa, vb, O0, 0, 0, 0);
                    else O1 = __builtin_amdgcn_mfma_f32_32x32x16_bf16(pa, vb, O1, 0, 0, 0);
                }
            }
            asm volatile("s_waitcnt lgkmcnt(0)" ::: "memory");
        }
    }
    asm volatile("" ::: "memory");
#pragma unroll
    for (int rr = 0; rr < 16; ++rr) { const int q = crow(rr, hi);
        *(LAS bf16_t*)(vl + q * 128 + ql * 2) = (bf16_t)(pk2(O0[rr], 0.f) & 0xffffu);
        *(LAS bf16_t*)(vl + q * 128 + (32 + ql) * 2) = (bf16_t)(pk2(O1[rr], 0.f) & 0xffffu); }
    asm volatile("s_waitcnt lgkmcnt(0)" ::: "memory");
#pragma unroll
    for (int i = 0; i < 4; ++i) { const int rq = 8 * i + (lane >> 3), ch = lane & 7;
        const u32x4 v = *(const LAS u32x4*)(vl + rq * 128 + ch * 16);
        *(u32x4*)(QK + (rowbase + (size_t)(i0 + rq) * dil) * 3072 + hh * 64 + ch * 8) = v; }
    asm volatile("s_waitcnt lgkmcnt(0)" ::: "memory");
}

__device__ __forceinline__ float transpose_reduce32(float (&a)[32], int lane) {
#pragma unroll
    for (int n = 16; n >= 1; n >>= 1) {
        const bool bit = (lane & n) != 0;
#pragma unroll
        for (int i = 0; i < n; ++i) { const float lo = a[i], hv = a[i + n]; const float send = bit ? lo : hv, keep = bit ? hv : lo; a[i] = keep + __shfl_xor(send, n); }
    }
    return a[0] + __shfl_xor(a[0], 32);
}

__global__ void __launch_bounds__(512, 2) mk_fwd(Args args) {
    extern __shared__ __attribute__((aligned(16))) unsigned char lds_raw[];
    LAS unsigned char* lds = (LAS unsigned char*)lds_raw;
    cg::grid_group grid = cg::this_grid();
    const int tid = threadIdx.x, lane = tid & 63, wave = __builtin_amdgcn_readfirstlane(tid >> 6);
    const int G = gridDim.x, bx = blockIdx.x;
    const int vcu = (G % 8 == 0) ? (bx % 8) * (G / 8) + bx / 8 : bx;
    const int gw = vcu * 8 + wave, NGW = G * 8;
    const int gtid = bx * 512 + tid, NT = G * 512;
    unsigned char* ws = args.ws;
    const float* x = args.in[0];
    float* out = args.out;
    float* cs = (float*)(ws + WS_CS);
    float* ss = (float*)(ws + WS_SS);
    float* vst = (float*)(ws + WS_VST);
    float* lse2 = (float*)(ws + WS_LSE);
    bf16_t* Win0 = (bf16_t*)(ws + WS_WIN0); bf16_t* Wout0 = (bf16_t*)(ws + WS_WOUT0); bf16_t* W1_0 = (bf16_t*)(ws + WS_W1_0); bf16_t* W2_0 = (bf16_t*)(ws + WS_W2_0);
    bf16_t* Win1 = (bf16_t*)(ws + WS_WIN1); bf16_t* Wout1 = (bf16_t*)(ws + WS_WOUT1); bf16_t* W1_1 = (bf16_t*)(ws + WS_W1_1); bf16_t* W2_1 = (bf16_t*)(ws + WS_W2_1);
    bf16_t* R1 = (bf16_t*)(ws + WS_R1); bf16_t* GLU = (bf16_t*)(ws + WS_GLU); bf16_t* H1B = (bf16_t*)(ws + WS_H1B);
    bf16_t* QK = (bf16_t*)(ws + WS_QK); bf16_t* VB = (bf16_t*)(ws + WS_V); bf16_t* U = (bf16_t*)(ws + WS_U);
    bf16_t* GB = (bf16_t*)(ws + WS_GB); bf16_t* GG = (bf16_t*)(ws + WS_G); bf16_t* UB = (bf16_t*)(ws + WS_UB); bf16_t* VT = (bf16_t*)(ws + WS_VT); bf16_t* MIX1 = (bf16_t*)(ws + WS_MIX1);

    {
        for (int i = gtid; i < 4 * M + 2 * M; i += NT) { if (i < 4 * M) ss[M + i] = 0.f; else vst[i - 4 * M] = 0.f; }
        for (int i = gtid; i < SEQ * 32; i += NT) { const int s = i >> 5, f = i & 31; const float inv = powf(10000.0f, -(float)f / 32.0f); const float ang = (float)s * inv; float sn, c; sincosf(ang, &sn, &c); cs[2 * i] = c; cs[2 * i + 1] = sn; }
        LAS float* scr = (LAS float*)(lds + wave * 16384);
        constexpr int I_IN0 = 16 * (NIN0 / 32), I_OUT = 16 * 32, I_W1 = 16 * (FF / 32), I_W2 = 64 * 32, I_IN1 = 16 * (NIN1 / 32);
        constexpr int NITEMS = I_IN0 + I_OUT + I_W1 + I_W2 + I_IN1 + I_OUT + I_W1 + I_W2;
        for (int it = gw; it < NITEMS; it += NGW) {
            int q = it;
            if (q < I_IN0) { transpose_item<1>(args.in[3], 1024, NIN0, args.in[1], Win0, scr, q, lane); continue; } q -= I_IN0;
            if (q < I_OUT) { transpose_item<0>(args.in[8], 1024, 1024, nullptr, Wout0, scr, q, lane); continue; } q -= I_OUT;
            if (q < I_W1) { transpose_item<0>(args.in[16], 1024, FF, args.in[2], W1_0, scr, q, lane); continue; } q -= I_W1;
            if (q < I_W2) { transpose_item<0>(args.in[17], FF, 1024, nullptr, W2_0, scr, q, lane); continue; } q -= I_W2;
            if (q < I_IN1) { transpose_item<2>(args.in[9], 1024, NIN1, args.in[1] + 1024, Win1, scr, q, lane); continue; } q -= I_IN1;
            if (q < I_OUT) { transpose_item<0>(args.in[15], 1024, 1024, nullptr, Wout1, scr, q, lane); continue; } q -= I_OUT;
            if (q < I_W1) { transpose_item<0>(args.in[16] + (size_t)1024 * FF, 1024, FF, args.in[2] + 1024, W1_1, scr, q, lane); continue; } q -= I_W1;
            transpose_item<0>(args.in[17] + (size_t)FF * 1024, FF, 1024, nullptr, W2_1, scr, q, lane);
        }
        for (int row = gw; row < M; row += NGW) {
            const f32x4* xr = (const f32x4*)(x + (size_t)row * 1024) + lane; float s = 0.f;
            unsigned long long* o8 = (unsigned long long*)(R1 + (size_t)row * 1024) + lane;
#pragma unroll
            for (int j = 0; j < 4; ++j) { const f32x4 v = xr[64 * j]; s += (v[0] * v[0] + v[1] * v[1]) + (v[2] * v[2] + v[3] * v[3]); o8[64 * j] = (unsigned long long)pk2(v[0], v[1]) | ((unsigned long long)pk2(v[2], v[3]) << 32); }
            s = wave_sum(s); if (lane == 0) ss[row] = s;
        }
    }
    grid.sync();
    {
        pg8::Gemm g{R1, Win0, M, NIN0, 1024}; pg8::StaticOrder S; S.init(M, NIN0, G, bx);
        pg8::EpiP p{}; p.ss = ss; p.o0 = GLU; p.o1 = QK; p.o2 = VB; p.cs = cs;
        pg8::Epi<0> E{p};
        pg8::gemm_phase<pg8::Epi<0>, pg8::StaticOrder, true, true>(lds, g, S, E);
    }
    grid.sync();
    {
#ifndef NO_ATTN
        for (int unit = vcu; unit < 256; unit += G) {
            const int b = unit >> 5, h = (unit >> 2) & 7, tb = unit & 3;
            LAS unsigned char* vl = lds + wave * 4096;
            for (int k = 0; k < 6; ++k) {
                const int wu = __builtin_amdgcn_readfirstlane(k * 8 + wave);
                const int g = wu >> 4, e = wu & 15;
                int r, i0;
                if (g == 0) { r = 0; i0 = tb * 512 + 32 * e; }
                else if (g == 1) { r = e & 3; i0 = tb * 128 + 32 * (e >> 2); }
                else { r = e; i0 = tb * 32; }
                attn_wave_unit(QK, VB, lse2, b, g, h, r, i0, vl, lane);
            }
            asm volatile("s_waitcnt vmcnt(0)" ::: "memory");
            __syncthreads();
#pragma unroll 2
            for (int it = 0; it < 8; ++it) {
                const int tl = it * 64 + (tid >> 3), ch = tid & 7; const size_t row = (size_t)b * SEQ + tb * 512 + tl;
                const float l0 = lse2[((size_t)0 * M + row) * 8 + h], l1 = lse2[((size_t)1 * M + row) * 8 + h], l2 = lse2[((size_t)2 * M + row) * 8 + h];
                const float mxl = fmaxf(l0, fmaxf(l1, l2));
                float e0 = __builtin_amdgcn_exp2f(l0 - mxl), e1 = __builtin_amdgcn_exp2f(l1 - mxl), e2 = __builtin_amdgcn_exp2f(l2 - mxl);
                const float inv = 1.f / (e0 + e1 + e2); e0 *= inv; e1 *= inv; e2 *= inv;
                const u32x4 a0 = *(const u32x4*)(QK + row * 3072 + (0 + h) * 64 + ch * 8), a1 = *(const u32x4*)(QK + row * 3072 + (8 + h) * 64 + ch * 8), a2 = *(const u32x4*)(QK + row * 3072 + (16 + h) * 64 + ch * 8);
                u32x4 o;
#pragma unroll
                for (int w = 0; w < 4; ++w) o[w] = pk2(e0 * bflo(a0[w]) + e1 * bflo(a1[w]) + e2 * bflo(a2[w]), e0 * bfhi(a0[w]) + e1 * bfhi(a1[w]) + e2 * bfhi(a2[w]));
                *(u32x4*)(R1 + row * 1024 + 512 + h * 64 + ch * 8) = o;
            }
            __syncthreads();
        }
#endif
#ifndef NO_CONV
        const float* ck = args.in[4]; const float* cb = args.in[5]; const float* lg = args.in[6]; const float* lb = args.in[7];
        LAS float* part = (LAS float*)(lds + 65536); LAS float* stat = (LAS float*)(lds + 65536 + 4096);
        for (int tile = vcu; tile < 512; tile += G) {
            const int t0 = tile * 32, tseq = t0 & 2047;
            for (int idx = tid; idx < 62 * 64; idx += 512) { const int rr = idx >> 6, ch = idx & 63; u32x4 v = {0u, 0u, 0u, 0u};
                if (tseq - 30 + rr >= 0) v = *(const u32x4*)(GLU + (size_t)(t0 - 30 + rr) * 512 + ch * 8);
                *(LAS u32x4*)(lds + rr * 1024 + ch * 16) = v; }
            __syncthreads();
            const int c = tid;
            float o[32];
            {
                float kk[31];
#pragma unroll
                for (int j = 0; j < 31; ++j) kk[j] = ck[j * 512 + c];
                const float bias = cb[c];
#pragma unroll
                for (int t = 0; t < 32; ++t) o[t] = bias;
#pragma unroll
                for (int i = 0; i < 62; ++i) {
                    const float xi = bf2f(*(const LAS bf16_t*)(lds + i * 1024 + c * 2));
#pragma unroll
                    for (int t = 0; t < 32; ++t) if (i - t >= 0 && i - t <= 30) o[t] += kk[i - t] * xi;
                }
            }
            {
                float a[32];
#pragma unroll
                for (int t = 0; t < 32; ++t) a[t] = o[t];
                const float s1 = transpose_reduce32(a, lane);
#pragma unroll
                for (int t = 0; t < 32; ++t) a[t] = o[t] * o[t];
                const float s2 = transpose_reduce32(a, lane);
                if (lane < 32) { part[(lane * 8 + wave) * 2] = s1; part[(lane * 8 + wave) * 2 + 1] = s2; }
            }
            __syncthreads();
            if (tid < 32) { float s1 = 0.f, s2 = 0.f;
#pragma unroll
                for (int w = 0; w < 8; ++w) { s1 += part[(tid * 8 + w) * 2]; s2 += part[(tid * 8 + w) * 2 + 1]; }
                const float mean = s1 * (1.f / 512.f), var = s2 * (1.f / 512.f) - mean * mean;
                stat[2 * tid] = mean; stat[2 * tid + 1] = rsqrtf(fmaxf(var, 0.f) + EPS); }
            __syncthreads();
            const float lgc = lg[c], lbc = lb[c];
#pragma unroll
            for (int t = 0; t < 32; ++t) { const float mean = stat[2 * t], rstd = stat[2 * t + 1]; const float y = (o[t] - mean) * rstd * lgc + lbc; const float a = y * pg8::sigm(y);
                *(LAS bf16_t*)(lds + t * 1024 + c * 2) = (bf16_t)(pk2(a, 0.f) & 0xffffu); }
            __syncthreads();
            for (int idx = tid; idx < 32 * 64; idx += 512) { const int rr = idx >> 6, ch = idx & 63; const u32x4 v = *(const LAS u32x4*)(lds + rr * 1024 + ch * 16); *(u32x4*)(R1 + (size_t)(t0 + rr) * 1024 + ch * 8) = v; }
            __syncthreads();
        }
#endif
    }
    grid.sync();
    {
        pg8::Gemm g{R1, Wout0, M, 1024, 1024}; pg8::StaticOrder S; S.init(M, 1024, G, bx);
        pg8::EpiP p{}; p.resid = x; p.hout = out; p.hb = H1B; p.ss_out = ss + M;
        pg8::Epi<1> E{p};
        pg8::gemm_phase<pg8::Epi<1>, pg8::StaticOrder, true, true>(lds, g, S, E);
    }
    grid.sync();
    {
        pg8::Gemm g{H1B, W1_0, M, FF, 1024}; pg8::StaticOrder S; S.init(M, FF, G, bx);
        pg8::EpiP p{}; p.ss = ss + M; p.o0 = U;
        pg8::Epi<2> E{p};
        pg8::gemm_phase<pg8::Epi<2>, pg8::StaticOrder, true, true>(lds, g, S, E);
    }
    grid.sync();
    {
        pg8::Gemm g{U, W2_0, M, 1024, FF}; pg8::StaticOrder S; S.init(M, 1024, G, bx);
        pg8::EpiP p{}; p.resid = out; p.hout = out; p.hb = R1; p.ss_out = ss + 2 * M;
        pg8::Epi<1> E{p};
        pg8::gemm_phase<pg8::Epi<1>, pg8::StaticOrder, true, true>(lds, g, S, E);
    }
    grid.sync();
    {
        pg8::Gemm g{R1, Win1, M, NIN1, 1024}; pg8::StaticOrder S; S.init(M, NIN1, G, bx);
        pg8::EpiP p{}; p.ss = ss + 2 * M; p.o0 = GB; p.o1 = GG; p.o2 = UB; p.o3 = VT; p.vst = vst;
        pg8::Epi<3> E{p};
        pg8::gemm_phase<pg8::Epi<3>, pg8::StaticOrder, true, true>(lds, g, S, E);
    }
    grid.sync();
    {
        const float* sk = args.in[10]; const float* lg = args.in[11]; const float* lb = args.in[12]; const float* sgw = args.in[13]; const float* sgb = args.in[14];
        for (int idx = gtid; idx < M * 64; idx += NT) {
            const int row = idx >> 6, ch = idx & 63, tseq = row & 2047;
            const u32x4 gbv = *(const u32x4*)(GB + (size_t)row * 512 + ch * 8);
            float acc[8];
#pragma unroll
            for (int e = 0; e < 8; ++e) acc[e] = 0.f;
#pragma unroll
            for (int j = 0; j < 3; ++j) {
                if (tseq - 2 + j >= 0) {
                    const u32x4 gv = *(const u32x4*)(GG + (size_t)(row - 2 + j) * 512 + ch * 8);
                    const f32x4 k0 = *(const f32x4*)(sk + j * 512 + ch * 8), k1 = *(const f32x4*)(sk + j * 512 + ch * 8 + 4);
                    acc[0] += k0[0] * bflo(gv[0]); acc[1] += k0[1] * bfhi(gv[0]); acc[2] += k0[2] * bflo(gv[1]); acc[3] += k0[3] * bfhi(gv[1]);
                    acc[4] += k1[0] * bflo(gv[2]); acc[5] += k1[1] * bfhi(gv[2]); acc[6] += k1[2] * bflo(gv[3]); acc[7] += k1[3] * bfhi(gv[3]);
                }
            }
            u32x4 o;
#pragma unroll
            for (int w = 0; w < 4; ++w) o[w] = pk2(bflo(gbv[w]) * acc[2 * w], bfhi(gbv[w]) * acc[2 * w + 1]);
            *(u32x4*)(MIX1 + (size_t)row * 1024 + ch * 8) = o;
        }
#ifndef NO_SGU
        LAS float* RS = (LAS float*)lds; LAS float* MU = RS + 128; LAS float* RHO = RS + 256; LAS float* SIG = RS + 384;
        const int ql = lane & 31, hi = lane >> 5;
        for (int unit = vcu; unit < 512; unit += G) {
            const int n = unit >> 2, gi = unit & 3, tok0 = n * 128;
            if (tid < 128) { const float sm = vst[2 * (tok0 + tid)], sq = vst[2 * (tok0 + tid) + 1]; const float mean = sm * (1.f / 512.f), var = sq * (1.f / 512.f) - mean * mean;
                RS[tid] = rsqrtf(fmaxf(var, 0.f) + EPS); MU[tid] = mean; }
            __syncthreads();
            if (tid < 128) { const float* wr_ = sgw + ((size_t)gi * 128 + tid) * 128; float sg = 0.f, rho = 0.f;
                for (int s = 0; s <= tid; ++s) { const float w = wr_[s]; sg += w; rho += w * RS[s] * MU[s]; }
                RHO[tid] = rho; SIG[tid] = sg; }
            const int tr = wave >> 1, tc0 = (wave & 1) * 2;
            f32x16 D0 = {}, D1 = {};
            const int t = 32 * tr + ql;
            const float* wp = sgw + ((size_t)gi * 128 + t) * 128 + 8 * hi;
            const bf16_t* vp0 = VT + ((size_t)gi * 128 + 32 * tc0 + ql) * M + tok0 + 8 * hi;
            const bf16_t* vp1 = vp0 + (size_t)32 * M;
            for (int s0 = 0; s0 < 32 * (tr + 1); s0 += 16) {
                const f32x4 w0 = *(const f32x4*)(wp + s0), w1 = *(const f32x4*)(wp + s0 + 4);
                float av[8];
#pragma unroll
                for (int j = 0; j < 4; ++j) { av[j] = w0[j]; av[j + 4] = w1[j]; }
#pragma unroll
                for (int j = 0; j < 8; ++j) { const int s = s0 + 8 * hi + j; av[j] = (s <= t) ? av[j] * RS[s] : 0.f; }
                u32x4 aw; aw.x = pk2(av[0], av[1]); aw.y = pk2(av[2], av[3]); aw.z = pk2(av[4], av[5]); aw.w = pk2(av[6], av[7]);
                const bf16x8 af = __builtin_bit_cast(bf16x8, aw);
                const bf16x8 b0 = *(const bf16x8*)(vp0 + s0), b1 = *(const bf16x8*)(vp1 + s0);
                D0 = __builtin_amdgcn_mfma_f32_32x32x16_bf16(af, b0, D0, 0, 0, 0);
                D1 = __builtin_amdgcn_mfma_f32_32x32x16_bf16(af, b1, D1, 0, 0, 0);
            }
            __syncthreads();
#pragma unroll
            for (int q = 0; q < 2; ++q) {
                const int chn = gi * 128 + 32 * (tc0 + q) + ql; const float lgc = lg[chn], lbc = lb[chn];
#pragma unroll
                for (int rr = 0; rr < 16; ++rr) { const int tt = 32 * tr + crow(rr, hi); const size_t token = (size_t)tok0 + tt;
                    const float dv = (q == 0) ? D0[rr] : D1[rr];
                    const float val = lgc * (dv - RHO[tt]) + lbc * SIG[tt] + sgb[gi * 128 + tt];
                    const float uu = bf2f(UB[token * 512 + chn]);
                    MIX1[token * 1024 + 512 + chn] = (bf16_t)(pk2(uu * val, 0.f) & 0xffffu); }
            }
            __syncthreads();
        }
#endif
    }
    grid.sync();
    {
        pg8::Gemm g{MIX1, Wout1, M, 1024, 1024}; pg8::StaticOrder S; S.init(M, 1024, G, bx);
        pg8::EpiP p{}; p.resid = out; p.hout = out; p.hb = R1; p.ss_out = ss + 3 * M;
        pg8::Epi<1> E{p};
        pg8::gemm_phase<pg8::Epi<1>, pg8::StaticOrder, true, true>(lds, g, S, E);
    }
    grid.sync();
    {
        pg8::Gemm g{R1, W1_1, M, FF, 1024}; pg8::StaticOrder S; S.init(M, FF, G, bx);
        pg8::EpiP p{}; p.ss = ss + 3 * M; p.o0 = U;
        pg8::Epi<2> E{p};
        pg8::gemm_phase<pg8::Epi<2>, pg8::StaticOrder, true, true>(lds, g, S, E);
    }
    grid.sync();
    {
        pg8::Gemm g{U, W2_1, M, 1024, FF}; pg8::StaticOrder S; S.init(M, 1024, G, bx);
        pg8::EpiP p{}; p.resid = out; p.hout = out; p.hb = nullptr; p.ss_out = ss + 4 * M;
        pg8::Epi<1> E{p};
        pg8::gemm_phase<pg8::Epi<1>, pg8::StaticOrder, true, true>(lds, g, S, E);
    }
    grid.sync();
    {
        const float* fg = args.in[18];
        for (int row = gw; row < M; row += NGW) {
            const float r = rsqrtf(ss[4 * M + row] * (1.f / 1024.f) + EPS);
            f32x4* orow = (f32x4*)(out + (size_t)row * 1024) + lane; const f32x4* gr = (const f32x4*)fg + lane;
#pragma unroll
            for (int j = 0; j < 4; ++j) { const f32x4 v = orow[64 * j]; orow[64 * j] = v * r * gr[64 * j]; }
        }
    }
}

extern "C" void kernel_launch(void* const* d_in, const int* in_sizes, int n_in, void* d_out, int out_size, void* d_ws, size_t ws_size, hipStream_t stream) {
    static int grid = 0;
    if (grid == 0) {
        if (n_in != 19 || out_size != M * DM || ws_size < WS_END) { fprintf(stderr, "kernel_launch: unexpected shapes (n_in %d out %d ws %zu)\n", n_in, out_size, ws_size); grid = -1; return; }
        int dev = 0, cus = 0, per_cu = 0;
        hipGetDevice(&dev); hipDeviceGetAttribute(&cus, hipDeviceAttributeMultiprocessorCount, dev);
        if (hipFuncSetAttribute((const void*)mk_fwd, hipFuncAttributeMaxDynamicSharedMemorySize, LDS_BYTES) != hipSuccess) { fprintf(stderr, "kernel_launch: hipFuncSetAttribute failed\n"); grid = -1; return; }
        if (hipOccupancyMaxActiveBlocksPerMultiprocessor(&per_cu, (const void*)mk_fwd, 512, LDS_BYTES) != hipSuccess || per_cu < 1) { fprintf(stderr, "kernel_launch: occupancy query says %d\n", per_cu); per_cu = 1; }
        (void)hipGetLastError();
        grid = cus;
        fprintf(stderr, "kernel_launch: cus %d per_cu %d grid %d\n", cus, per_cu, grid);
    }
    if (grid < 0) return;
    Args a{};
    for (int i = 0; i < 19; ++i) a.in[i] = (const float*)d_in[i];
    a.out = (float*)d_out; a.ws = (unsigned char*)d_ws;
    void* kargs[] = {&a};
    hipError_t e = hipLaunchCooperativeKernel((const void*)mk_fwd, dim3(grid), dim3(512), kargs, LDS_BYTES, stream);
    if (e != hipSuccess) fprintf(stderr, "cooperative launch failed: %s (grid %d)\n", hipGetErrorString(e), grid);
}
```

```cpp
#include <hip/hip_runtime.h>
#include <hip/hip_cooperative_groups.h>
#include <cstdio>
#include <cstdint>
namespace cg = cooperative_groups;

#ifndef MK_CHECK
#define MK_CHECK 0
#endif

constexpr int M = 16384, DM = 1024, SEQ = 2048, NIN0 = 5632, NIN1 = 2560, FF = 4096;
constexpr float EPS = 1e-6f;
constexpr float QSCALE = 0.125f * 1.4426950408889634f;
constexpr size_t MiB = 1u << 20;
constexpr size_t WS_CTL = 0;
constexpr size_t WS_CS = 1 * MiB;
constexpr size_t WS_SS = WS_CS + 512 * 1024;
constexpr size_t WS_VST = WS_SS + 5 * M * 4;
constexpr size_t WS_LSE = 2 * MiB;
constexpr size_t WS_W = 4 * MiB;
constexpr size_t WS_WIN0 = WS_W, WS_WOUT0 = WS_WIN0 + 11 * MiB, WS_W1_0 = WS_WOUT0 + 2 * MiB, WS_W2_0 = WS_W1_0 + 8 * MiB;
constexpr size_t WS_WIN1 = WS_W2_0 + 8 * MiB, WS_WOUT1 = WS_WIN1 + 5 * MiB, WS_W1_1 = WS_WOUT1 + 2 * MiB, WS_W2_1 = WS_W1_1 + 8 * MiB;
constexpr size_t WS_R1 = 56 * MiB;
constexpr size_t WS_GLU = 88 * MiB;
constexpr size_t WS_H1B = 88 * MiB;
constexpr size_t WS_QK = 104 * MiB;
constexpr size_t WS_V = 200 * MiB;
constexpr size_t WS_U = 120 * MiB;
constexpr size_t WS_GB = 88 * MiB, WS_G = 104 * MiB, WS_UB = 120 * MiB, WS_VT = 136 * MiB, WS_MIX1 = 152 * MiB;
constexpr size_t WS_END = 248 * MiB;
static_assert(WS_W2_1 + 8 * MiB == WS_R1, "weights end at R1");
constexpr int LDS_BYTES = 147456;

namespace pg8 {
#define PG8_LAS __attribute__((address_space(3)))
typedef unsigned short bf16_t;
typedef short bf16x8 __attribute__((ext_vector_type(8)));
typedef float f32x4 __attribute__((ext_vector_type(4)));
typedef unsigned u32x4 __attribute__((ext_vector_type(4)));
constexpr int BM = 256, BK = 64, HALF = 128, HTB = HALF * BK * 2  , STAGE_BYTES = 8 * HTB, NXCD = 8, WGM = 8;

__host__ __device__ __forceinline__ int lds_byte(int r, int c) { const int st = (r >> 4) * 2 + (c >> 5), rr = r & 15, cc = c & 31, ob = rr * 64 + cc * 2; return st * 1024 + (ob ^ (((ob >> 9) & 1) << 5)); }
__host__ __device__ __forceinline__ void stage_rc(int b, int& R, int& C) { const int st = b / 1024, sb = b % 1024, swz = sb ^ (((sb >> 9) & 1) << 5); R = (st >> 1) * 16 + swz / 64; C = (st & 1) * 32 + (swz % 64) / 2; }
__host__ __device__ __forceinline__ int perm32(int rho) { const int n = rho >> 4, i = rho & 15; return 8 * (i >> 2) + 4 * n + (i & 3); }

struct Unit { int pm, pn; };
struct Gemm { const bf16_t* A; const bf16_t* Bt; int M, N, K; };

struct StaticOrder {
    int nM, nN, nwg, G, c;
    __host__ __device__ void init(int M, int N, int G_, int c_) { nM = M / BM; nN = N / BM; nwg = nM * nN; G = G_; c = c_; }
    __host__ __device__ bool next(int i, Unit& u) const {
        const long L = (long)i * G + c; if (L >= nwg) return false;
        int wgid = (int)L; { const int q = nwg / NXCD, r = nwg % NXCD, xcd = wgid % NXCD, off = wgid / NXCD; wgid = (xcd < r ? xcd * (q + 1) : r * (q + 1) + (xcd - r) * q) + off; }
        const int nig = WGM * nN, gid = wgid / nig, fm = gid * WGM, gsz = (nM - fm) < WGM ? (nM - fm) : WGM;
        u.pm = fm + ((wgid % nig) % gsz); u.pn = (wgid % nig) / gsz; return true;
    }
    __device__ __forceinline__ void a_ready(const Unit&) const {}
    __device__ __forceinline__ void done(const Unit&) const {}
};

__device__ __forceinline__ unsigned cvt_pk_bf16(float lo, float hi) { unsigned r; asm volatile("v_cvt_pk_bf16_f32 %0, %1, %2" : "=v"(r) : "v"(lo), "v"(hi)); return r; }
typedef float f32x2 __attribute__((ext_vector_type(2)));
typedef unsigned u32x2 __attribute__((ext_vector_type(2)));
__device__ __forceinline__ void store8(bf16_t* p, const f32x4& a, const f32x4& b) { u32x4 w; w.x = cvt_pk_bf16(a[0], a[1]); w.y = cvt_pk_bf16(a[2], a[3]); w.z = cvt_pk_bf16(b[0], b[1]); w.w = cvt_pk_bf16(b[2], b[3]); *(u32x4*)p = w; }
__device__ __forceinline__ void store4(bf16_t* p, const f32x4& a) { u32x2 w; w.x = cvt_pk_bf16(a[0], a[1]); w.y = cvt_pk_bf16(a[2], a[3]); *(u32x2*)p = w; }
__device__ __forceinline__ float sigm(float x) { return __builtin_amdgcn_rcpf(1.f + __expf(-x)); }
__device__ __forceinline__ float gelu_t(float x) { const float t = 1.5957691216057308f * (x + 0.044715f * x * x * x); return x * sigm(t); }
struct EpiP {
    const float* ss; float* ss_out; const float* resid; float* hout; bf16_t* hb;
    bf16_t* o0; bf16_t* o1; bf16_t* o2; bf16_t* o3; const float* cs; float* vst;
};
template <int KIND> struct Epi {
    static constexpr bool PERM = true, AFTER_DRAIN = false;
    EpiP p;
    __device__ __forceinline__ void operator()(const f32x4 (&acc)[2][2][4][2], const Unit& u, int wr, int wc, int fr, int fq) const {
        const int colt = u.pn * BM + wc * 32 + 8 * fq;
#pragma unroll
        for (int ai = 0; ai < 2; ++ai)
#pragma unroll
            for (int m = 0; m < 4; ++m) {
                const int row = u.pm * BM + ai * HALF + wr * 64 + m * 16 + fr;
                float r = 1.f;
                if (KIND != 1) r = rsqrtf(p.ss[row] * (1.f / 1024.f) + 1e-6f);
                float sq = 0.f, s1 = 0.f;
#pragma unroll
                for (int bj = 0; bj < 2; ++bj) {
                    const int c0 = colt + bj * HALF;
                    f32x4 v0 = acc[ai][bj][m][0] * r, v1 = acc[ai][bj][m][1] * r;
                    if (KIND == 0) {
                        if (u.pn < 4) {
                            f32x4 o;
#pragma unroll
                            for (int j = 0; j < 4; ++j) o[j] = v0[j] * sigm(v1[j]);
                            store4(p.o0 + (size_t)row * 512 + (c0 >> 1), o);
                        } else if (u.pn < 16) {
                            const int qq = ((c0 - 1024) & 63) >> 3, pos = row & 2047;
                            const f32x4* t = (const f32x4*)(p.cs + ((size_t)pos * 32 + 4 * qq) * 2);
                            const f32x4 t0 = t[0], t1 = t[1];
                            const f32x4 cc = {t0[0], t0[2], t1[0], t1[2]}, sn = {t0[1], t0[3], t1[1], t1[3]};
                            f32x4 o1 = v0 * cc - v1 * sn, o2 = v1 * cc + v0 * sn;
                            if (u.pn < 10) { o1 = o1 * QSCALE; o2 = o2 * QSCALE; }
                            store8(p.o1 + (size_t)row * 3072 + (c0 - 1024), o1, o2);
                        } else {
                            store8(p.o2 + (size_t)row * 1536 + (c0 - 4096), v0, v1);
                        }
                    } else if (KIND == 1) {
                        const size_t off = (size_t)row * 1024 + c0;
                        const f32x4 r0 = *(const f32x4*)(p.resid + off), r1 = *(const f32x4*)(p.resid + off + 4);
                        v0 = v0 + r0; v1 = v1 + r1;
                        *(f32x4*)(p.hout + off) = v0; *(f32x4*)(p.hout + off + 4) = v1;
                        if (p.hb) store8(p.hb + off, v0, v1);
#pragma unroll
                        for (int j = 0; j < 4; ++j) sq += v0[j] * v0[j] + v1[j] * v1[j];
                    } else if (KIND == 2) {
#pragma unroll
                        for (int j = 0; j < 4; ++j) { float a = fmaxf(v0[j], 0.f), b = fmaxf(v1[j], 0.f); v0[j] = a * a; v1[j] = b * b; }
                        store8(p.o0 + (size_t)row * 4096 + c0, v0, v1);
                    } else {
                        if (u.pn < 2) store8(p.o0 + (size_t)row * 512 + c0, v0, v1);
                        else if (u.pn < 6) { const f32x4 o = v0 * v1; store4(p.o1 + (size_t)row * 512 + ((c0 - 512) >> 1), o); }
                        else if (u.pn < 8) {
#pragma unroll
                            for (int j = 0; j < 4; ++j) { v0[j] = gelu_t(v0[j]); v1[j] = gelu_t(v1[j]); }
                            store8(p.o2 + (size_t)row * 512 + (c0 - 1536), v0, v1);
                        } else {
                            bf16_t* vt = p.o3 + (size_t)(c0 - 2048) * ::M + row;
#pragma unroll
                            for (int j = 0; j < 4; ++j) { v0[j] = gelu_t(v0[j]); v1[j] = gelu_t(v1[j]); s1 += v0[j] + v1[j]; sq += v0[j] * v0[j] + v1[j] * v1[j]; }
#pragma unroll
                            for (int j = 0; j < 4; ++j) { vt[(size_t)j * ::M] = (bf16_t)(cvt_pk_bf16(v0[j], 0.f) & 0xffffu); vt[(size_t)(j + 4) * ::M] = (bf16_t)(cvt_pk_bf16(v1[j], 0.f) & 0xffffu); }
                        }
                    }
                }
                if (KIND == 1) {
                    sq += __shfl_xor(sq, 16); sq += __shfl_xor(sq, 32);
                    if (fq == 0) atomicAdd(p.ss_out + row, sq);
                }
                if (KIND == 3) {
                    if (u.pn >= 8) {
                        sq += __shfl_xor(sq, 16); sq += __shfl_xor(sq, 32); s1 += __shfl_xor(s1, 16); s1 += __shfl_xor(s1, 32);
                        if (fq == 0) { atomicAdd(p.vst + 2 * row, s1); atomicAdd(p.vst + 2 * row + 1, sq); }
                    }
                }
            }
    }
};
template <class Epi, class Sched, bool ALIGN_EPI = false, bool SP2 = false>
__device__ __forceinline__ void gemm_phase(PG8_LAS unsigned char* lds, const Gemm g, const Sched& S, const Epi& E) {
    const int tid = threadIdx.x, wid = __builtin_amdgcn_readfirstlane(tid >> 6), lane = tid & 63, wr = wid >> 2, wc = wid & 3, fr = lane & 15, fq = lane >> 4;
    const int K = g.K, nt = K / BK;
    unsigned voffA[2], voffB[2];
#pragma unroll
    for (int i = 0; i < 2; ++i) { int R, C; stage_rc(tid * 16 + i * 8192, R, C); const int Rb = Epi::PERM ? ((R & ~31) + perm32(R & 31)) : R;
        voffA[i] = (unsigned)(R * K + C) * 2u; voffB[i] = (unsigned)(Rb * K + C) * 2u; }
    const size_t kstep = (size_t)(BK * 2);
    const size_t hstep = (size_t)HALF * K * 2;
    const size_t tstep = 2 * hstep;
    const unsigned ldsw = (unsigned)wid * 1024u;
    const int aoff = lds_byte(wr * 64 + fr, fq * 8), boff = lds_byte(wc * 32 + fr, fq * 8);
#define PG8_SA(b, h) (((b) * 2 + (h)) * HTB)
#define PG8_SB(b, h) ((4 + (b) * 2 + (h)) * HTB)
#define PG8_STAGE(bufoff, gbase, voff) do { _Pragma("unroll") for (int _i = 0; _i < 2; ++_i) \
        __builtin_amdgcn_global_load_lds((const unsigned*)((const char*)(gbase) + (voff)[_i]), (PG8_LAS unsigned*)(lds + (bufoff) + ldsw + _i * 8192), 16, 0, 0); } while (0)
#define PG8_LDA(dst, b, h) do { _Pragma("unroll") for (int m = 0; m < 4; ++m) _Pragma("unroll") for (int k = 0; k < 2; ++k) dst[m][k] = *(const PG8_LAS bf16x8*)(lds + PG8_SA(b, h) + aoff + m * 2048 + k * 1024); } while (0)
#define PG8_LDB(dst, b, h) do { _Pragma("unroll") for (int n = 0; n < 2; ++n) _Pragma("unroll") for (int k = 0; k < 2; ++k) dst[n][k] = *(const PG8_LAS bf16x8*)(lds + PG8_SB(b, h) + boff + n * 2048 + k * 1024); } while (0)
#define PG8_MMA(ai, bj, At, Bt) do { __builtin_amdgcn_s_setprio(1); _Pragma("unroll") for (int m = 0; m < 4; ++m) _Pragma("unroll") for (int n = 0; n < 2; ++n) _Pragma("unroll") for (int k = 0; k < 2; ++k) \
        acc[ai][bj][m][n] = __builtin_amdgcn_mfma_f32_16x16x32_bf16(Bt[n][k], At[m][k], acc[ai][bj][m][n], 0, 0, 0); __builtin_amdgcn_s_setprio(0); } while (0)
#define PG8_WAIT_V(n) asm volatile("s_waitcnt vmcnt(" #n ")" ::: "memory")
#define PG8_WAIT_L(n) asm volatile("s_waitcnt lgkmcnt(" #n ")" ::: "memory")
#define PG8_BAR __builtin_amdgcn_s_barrier()
#define PG8_SCHED __builtin_amdgcn_sched_barrier(0)
    Unit cur, nxt; int ui = 0;
    if (!S.next(0, cur)) return;
    f32x4 acc[2][2][4][2];
#pragma unroll
    for (int a = 0; a < 2; ++a)
#pragma unroll
        for (int b = 0; b < 2; ++b)
#pragma unroll
            for (int m = 0; m < 4; ++m)
#pragma unroll
                for (int n = 0; n < 2; ++n) acc[a][b][m][n] = (f32x4){0.f, 0.f, 0.f, 0.f};
    bf16x8 At[4][2], B0[2][2], B1[2][2];
    const char* cA = (const char*)g.A + (size_t)cur.pm * tstep; const char* cB = (const char*)g.Bt + (size_t)cur.pn * tstep;
    S.a_ready(cur);
    if constexpr (SP2) {
        PG8_STAGE(PG8_SB(0, 0), cB, voffB); PG8_STAGE(PG8_SB(0, 1), cB + hstep, voffB); PG8_STAGE(PG8_SA(0, 0), cA, voffA); PG8_STAGE(PG8_SA(0, 1), cA + hstep, voffA);
        if (wr == 1) PG8_BAR;
        PG8_WAIT_V(2); PG8_BAR;
        PG8_STAGE(PG8_SB(1, 0), cB + kstep, voffB); PG8_STAGE(PG8_SA(1, 0), cA + kstep, voffA); PG8_STAGE(PG8_SB(1, 1), cB + hstep + kstep, voffB);
        PG8_WAIT_V(6); PG8_BAR;
    } else {
        PG8_STAGE(PG8_SB(0, 0), cB, voffB); PG8_STAGE(PG8_SA(0, 0), cA, voffA); PG8_STAGE(PG8_SB(0, 1), cB + hstep, voffB); PG8_STAGE(PG8_SA(0, 1), cA + hstep, voffA);
        if (wr == 1) PG8_BAR;
        PG8_WAIT_V(4); PG8_BAR;
        PG8_STAGE(PG8_SB(1, 0), cB + kstep, voffB); PG8_STAGE(PG8_SA(1, 0), cA + kstep, voffA); PG8_STAGE(PG8_SB(1, 1), cB + hstep + kstep, voffB);
        PG8_WAIT_V(6); PG8_BAR;
    }
    for (;;) {
        const bool has_next = S.next(ui + 1, nxt);
        const char* nA = has_next ? (const char*)g.A + (size_t)nxt.pm * tstep : cA; const char* nB = has_next ? (const char*)g.Bt + (size_t)nxt.pn * tstep : cB;
        for (int t = 0; t < nt; t += 2) {
            const bool last = (t == nt - 2);
            const char* a1 = cA + (size_t)(t + 1) * kstep;
            const char* a2 = last ? nA : cA + (size_t)(t + 2) * kstep; const char* b2 = last ? nB : cB + (size_t)(t + 2) * kstep;
            const char* a3 = a2 + kstep; const char* b3 = b2 + kstep;
            if (last && has_next) S.a_ready(nxt);
            if constexpr (SP2) {
            PG8_LDB(B0, 0, 0); PG8_LDB(B1, 0, 1); PG8_SCHED; PG8_LDA(At, 0, 0); PG8_STAGE(PG8_SA(1, 1), a1 + hstep, voffA);
            PG8_WAIT_V(8); PG8_WAIT_L(0); PG8_BAR; PG8_MMA(0, 0, At, B0); PG8_MMA(0, 1, At, B1); PG8_BAR; PG8_SCHED;
            PG8_LDA(At, 0, 1); PG8_STAGE(PG8_SB(0, 0), b2, voffB); PG8_STAGE(PG8_SB(0, 1), b2 + hstep, voffB); PG8_STAGE(PG8_SA(0, 0), a2, voffA);
            PG8_WAIT_V(8); PG8_WAIT_L(0); PG8_BAR; PG8_MMA(1, 0, At, B0); PG8_MMA(1, 1, At, B1); PG8_BAR; PG8_SCHED;
            PG8_LDB(B0, 1, 0); PG8_LDB(B1, 1, 1); PG8_SCHED; PG8_LDA(At, 1, 0); PG8_STAGE(PG8_SA(0, 1), a2 + hstep, voffA);
            PG8_WAIT_V(8); PG8_WAIT_L(0); PG8_BAR; PG8_MMA(0, 0, At, B0); PG8_MMA(0, 1, At, B1); PG8_BAR; PG8_SCHED;
            PG8_LDA(At, 1, 1); PG8_STAGE(PG8_SB(1, 0), b3, voffB); PG8_STAGE(PG8_SB(1, 1), b3 + hstep, voffB); PG8_STAGE(PG8_SA(1, 0), a3, voffA);
            PG8_WAIT_V(8); PG8_WAIT_L(0); PG8_BAR; PG8_MMA(1, 0, At, B0); PG8_MMA(1, 1, At, B1); PG8_BAR; PG8_SCHED;
            } else {
            PG8_LDB(B0, 0, 0); PG8_SCHED; PG8_LDA(At, 0, 0); PG8_STAGE(PG8_SA(1, 1), a1 + hstep, voffA);
            PG8_WAIT_L(8); PG8_BAR; PG8_WAIT_L(0); PG8_MMA(0, 0, At, B0); PG8_BAR; PG8_SCHED;
            PG8_LDB(B1, 0, 1); PG8_STAGE(PG8_SB(0, 0), b2, voffB);
            PG8_BAR; PG8_WAIT_L(0); PG8_MMA(0, 1, At, B1); PG8_BAR;
            PG8_LDA(At, 0, 1); PG8_STAGE(PG8_SA(0, 0), a2, voffA);
            PG8_BAR; PG8_WAIT_L(0); PG8_MMA(1, 0, At, B0); PG8_BAR; PG8_SCHED;
            PG8_STAGE(PG8_SB(0, 1), b2 + hstep, voffB);
            PG8_WAIT_V(6); PG8_BAR; PG8_MMA(1, 1, At, B1); PG8_BAR;
            PG8_LDB(B0, 1, 0); PG8_SCHED; PG8_LDA(At, 1, 0); PG8_STAGE(PG8_SA(0, 1), a2 + hstep, voffA);
            PG8_WAIT_L(8); PG8_BAR; PG8_WAIT_L(0); PG8_MMA(0, 0, At, B0); PG8_BAR; PG8_SCHED;
            PG8_LDB(B1, 1, 1); PG8_STAGE(PG8_SB(1, 0), b3, voffB);
            PG8_BAR; PG8_WAIT_L(0); PG8_MMA(0, 1, At, B1); PG8_BAR;
            PG8_LDA(At, 1, 1); PG8_STAGE(PG8_SA(1, 0), a3, voffA);
            PG8_BAR; PG8_WAIT_L(0); PG8_MMA(1, 0, At, B0); PG8_BAR; PG8_SCHED;
            PG8_STAGE(PG8_SB(1, 1), b3 + hstep, voffB);
            PG8_WAIT_V(6); PG8_BAR; PG8_MMA(1, 1, At, B1); PG8_BAR;
            }
        }
        if constexpr (ALIGN_EPI) { if (wr == 0) PG8_BAR; }
        if constexpr (!Epi::AFTER_DRAIN) { E(acc, cur, wr, wc, fr, fq); S.done(cur); }
        if (!has_next) break;
#pragma unroll
        for (int a = 0; a < 2; ++a)
#pragma unroll
            for (int b = 0; b < 2; ++b)
#pragma unroll
                for (int m = 0; m < 4; ++m)
#pragma unroll
                    for (int n = 0; n < 2; ++n) acc[a][b][m][n] = (f32x4){0.f, 0.f, 0.f, 0.f};
        cur = nxt; cA = nA; cB = nB; ++ui;
        if constexpr (ALIGN_EPI) { if (wr == 1) PG8_BAR; }
    }
    PG8_WAIT_V(0);
    if constexpr (!ALIGN_EPI) { if (wr == 0) PG8_BAR; }
    PG8_BAR;
    if constexpr (Epi::AFTER_DRAIN) { E.fused(acc, cur, wr, wc, fr, fq, lds, wid, lane); S.done(cur); }
#undef PG8_SA
#undef PG8_SB
#undef PG8_STAGE
#undef PG8_LDA
#undef PG8_LDB
#undef PG8_MMA
#undef PG8_WAIT_V
#undef PG8_WAIT_L
#undef PG8_BAR
#undef PG8_SCHED
}
}
#define LAS __attribute__((address_space(3)))
typedef unsigned short bf16_t;
typedef short bf16x8 __attribute__((ext_vector_type(8)));
typedef short s16x4 __attribute__((ext_vector_type(4)));
typedef float f32x4 __attribute__((ext_vector_type(4)));
typedef float f32x16 __attribute__((ext_vector_type(16)));
typedef unsigned u32x4 __attribute__((ext_vector_type(4)));
typedef float f32x2_t __attribute__((ext_vector_type(2)));
typedef __bf16 bf16x2_t __attribute__((ext_vector_type(2)));
__device__ __forceinline__ unsigned pk2(float lo, float hi) { f32x2_t v = {lo, hi}; bf16x2_t b = __builtin_convertvector(v, bf16x2_t); return __builtin_bit_cast(unsigned, b); }
__device__ __forceinline__ float bf2f(unsigned short x) { return __uint_as_float((unsigned)x << 16); }
__device__ __forceinline__ float bflo(unsigned w) { return __uint_as_float(w << 16); }
__device__ __forceinline__ float bfhi(unsigned w) { return __uint_as_float(w & 0xffff0000u); }
__device__ __forceinline__ int crow(int r, int hi) { return (r & 3) + 8 * (r >> 2) + 4 * hi; }
__device__ __forceinline__ float wave_sum(float v) {
#pragma unroll
    for (int o = 1; o < 64; o <<= 1) v += __shfl_xor(v, o);
    return v;
}

#define GAS __attribute__((address_space(1)))
#define XB_TMO      128
#define XB_XCNT(j)  (256  + 64 * (j))
#define XB_XSUB(j)  (1280 + 64 * (j))
#define XB_XGEN(j)  (2304 + 64 * (j))
#define XB_TOP      3328
#define XB_TOPGEN   3392
#define XCD_BAR_WORDS 3456
#define XB_SPIN_CAP (1u << 18)

__device__ __forceinline__ unsigned xb_ld(unsigned* p)              { return __hip_atomic_load(p, __ATOMIC_RELAXED, __HIP_MEMORY_SCOPE_AGENT); }
__device__ __forceinline__ unsigned xb_add(unsigned* p, unsigned v) { return __hip_atomic_fetch_add(p, v, __ATOMIC_RELAXED, __HIP_MEMORY_SCOPE_AGENT); }
__device__ __forceinline__ unsigned xb_xcc_id() { return (unsigned)__builtin_amdgcn_s_getreg((3 << 11) | 20) & 0xFu; }
#define XB_SPIN(cond, bar) do { unsigned _sp = 0; while (cond) { __builtin_amdgcn_s_sleep(1); \
    if ((++_sp & 255u) == 0u) { if (xb_ld(&(bar)[XB_TMO])) break; if (_sp > XB_SPIN_CAP) { atomicAdd(&(bar)[XB_TMO], 1u); break; } } } } while (0)

struct XcdBarrier {
    unsigned* bar; unsigned x;
    volatile LAS unsigned* st;
};

__device__ __forceinline__ XcdBarrier xcd_barrier_post(unsigned* bar, volatile LAS unsigned* st) {
    XcdBarrier b; b.bar = bar; b.x = xb_xcc_id(); b.st = st;
    if (threadIdx.x == 0) (void)xb_add(&bar[XB_XCNT(b.x)], 1u);
    return b;
}
__device__ __forceinline__ void xcd_barrier_complete(unsigned* bar, unsigned x, unsigned& nloc, unsigned& nx) {
    const unsigned G = gridDim.x * gridDim.y * gridDim.z;
    unsigned sum, cnt, mine, sp = 0u;
    for (;;) {
        sum = 0u; cnt = 0u; mine = 0u;
#pragma unroll
        for (unsigned j = 0; j < 16; ++j) { const unsigned c = xb_ld(&bar[XB_XCNT(j)]); sum += c; cnt += (c > 0u) ? 1u : 0u; mine = (j == x) ? c : mine; }
        if (sum == G) break;
        __builtin_amdgcn_s_sleep(1);
        if ((++sp & 255u) == 0u) { if (xb_ld(&bar[XB_TMO])) break; if (sp > XB_SPIN_CAP) { atomicAdd(&bar[XB_TMO], 1u); break; } }
    }
    nloc = mine > 0u ? mine : 1u; nx = cnt > 0u ? cnt : 1u;
}

__device__ __forceinline__ void xcd_barrier(const XcdBarrier& b) {
    asm volatile("s_waitcnt vmcnt(0)" ::: "memory");
    __syncthreads();
    if (threadIdx.x == 0) {
        unsigned* bar = b.bar;
        __builtin_amdgcn_s_waitcnt(0);
        unsigned nloc = b.st[0], nx = b.st[1];
        if (nloc == 0u) { xcd_barrier_complete(bar, b.x, nloc, nx); b.st[0] = nloc; b.st[1] = nx; }
        const unsigned old = xb_add(&bar[XB_XSUB(b.x)], 1u);
        const unsigned gen = old / nloc;
        if (old + 1u == (gen + 1u) * nloc) {
            __builtin_amdgcn_fence(__ATOMIC_RELEASE, "agent");
            asm volatile("s_waitcnt vmcnt(0)" ::: "memory");
            const unsigned og = xb_add(&bar[XB_TOP], 1u);
            const unsigned tg = og / nx;
            if (og + 1u == (tg + 1u) * nx) xb_add(&bar[XB_TOPGEN], 1u);
            else XB_SPIN(xb_ld(&bar[XB_TOPGEN]) == tg, bar);
            __builtin_amdgcn_fence(__ATOMIC_ACQUIRE, "agent");
            xb_add(&bar[XB_XGEN(b.x)], 1u);
            asm volatile("s_waitcnt vmcnt(0)" ::: "memory");
        } else {
            XB_SPIN(xb_ld(&bar[XB_XGEN(b.x)]) == gen, bar);
            __builtin_amdgcn_fence(__ATOMIC_ACQUIRE, "agent");
            asm volatile("s_waitcnt vmcnt(0)" ::: "memory");
        }
    }
    __syncthreads();
}

struct Args { const float* in[19]; float* out; unsigned char* ws; };

__device__ __forceinline__ int perm_in0(int n) {
    if (n < 1024) { const int q8 = n >> 3, e = n & 7; return (e < 4) ? (4 * q8 + e) : (512 + 4 * q8 + (e - 4)); }
    if (n < 4096) { const int w = (n - 1024) & 63, hh = (n - 1024) >> 6, qq = w >> 3, e = w & 7; return 1024 + 64 * hh + 4 * qq + (e & 3) + ((e >= 4) ? 32 : 0); }
    return n;
}
__device__ __forceinline__ int perm_in1(int n) {
    if (n >= 512 && n < 1536) { const int mm = n - 512, q8 = mm >> 3, e = mm & 7; return (e < 4) ? (512 + 4 * q8 + e) : (1024 + 4 * q8 + (e - 4)); }
    return n;
}
template <int PERM>
__device__ __forceinline__ void transpose_item(const float* W, int K, int N, const float* kscale, bf16_t* WT, LAS float* scr, int item, int lane) {
    const int nblk = N / 32, kb = item / nblk, nb = item % nblk, k0 = 64 * kb, n0 = 32 * nb;
    const int nd = n0 + (lane & 31);
    const int ns = (PERM == 1) ? perm_in0(nd) : (PERM == 2) ? perm_in1(nd) : nd;
#pragma unroll 8
    for (int i = 0; i < 32; ++i) { const int kk = 2 * i + (lane >> 5); float w = W[(size_t)(k0 + kk) * N + ns]; if (kscale) w *= kscale[k0 + kk]; scr[kk * 33 + (lane & 31)] = w; }
    asm volatile("s_waitcnt lgkmcnt(0)" ::: "memory");
    const int c = lane & 7;
#pragma unroll
    for (int j = 0; j < 4; ++j) { const int n = (lane >> 3) + 8 * j; const LAS float* s = scr + (8 * c) * 33 + n;
        u32x4 o; o.x = pk2(s[0 * 33], s[1 * 33]); o.y = pk2(s[2 * 33], s[3 * 33]); o.z = pk2(s[4 * 33], s[5 * 33]); o.w = pk2(s[6 * 33], s[7 * 33]);
        *(u32x4*)(WT + (size_t)(n0 + n) * K + k0 + 8 * c) = o; }
    asm volatile("s_waitcnt lgkmcnt(0)" ::: "memory");
}

__device__ __forceinline__ s16x4 vtr(const LAS unsigned char* p) { typedef short v4i16_t __attribute__((ext_vector_type(4))); return __builtin_bit_cast(s16x4, __builtin_amdgcn_ds_read_tr16_b64_v4i16((LAS v4i16_t*)p)); }
__device__ __forceinline__ void attn_wave_unit(bf16_t* QK, const bf16_t* Vb, float* lse2, int b, int g, int h, int r, int i0, LAS unsigned char* vl, int lane) {
    const int dil = (g == 0) ? 1 : (g == 1 ? 4 : 16);
    const int hh = g * 8 + h, ql = lane & 31, hi = lane >> 5;
    const size_t rowbase = (size_t)b * SEQ + r;
    const bf16_t* qp = QK + (rowbase + (size_t)(i0 + ql) * dil) * 3072 + hh * 64 + hi * 8;
    bf16x8 qf[4];
#pragma unroll
    for (int s = 0; s < 4; ++s) qf[s] = *(const bf16x8*)(qp + 16 * s);
    f32x16 S[5];
    const float NEG = -INFINITY;
#pragma unroll
    for (int j = 0; j < 5; ++j) {
        const int kb = i0 - 128 + 32 * j;
        if (kb >= 0) {
            const bf16_t* kp = QK + (rowbase + (size_t)(kb + ql) * dil) * 3072 + 1536 + hh * 64 + hi * 8;
            f32x16 acc = {};
#pragma unroll
            for (int s = 0; s < 4; ++s) { const bf16x8 kf = *(const bf16x8*)(kp + 16 * s); acc = __builtin_amdgcn_mfma_f32_32x32x16_bf16(kf, qf[s], acc, 0, 0, 0); }
            if (j == 0) {
#pragma unroll
                for (int rr = 0; rr < 16; ++rr) if (crow(rr, hi) < ql) acc[rr] = NEG;
            }
            if (j == 4) {
#pragma unroll
                for (int rr = 0; rr < 16; ++rr) if (crow(rr, hi) > ql) acc[rr] = NEG;
            }
            S[j] = acc;
        } else {
#pragma unroll
            for (int rr = 0; rr < 16; ++rr) S[j][rr] = NEG;
        }
    }
    float mx = NEG;
#pragma unroll
    for (int j = 0; j < 5; ++j)
#pragma unroll
        for (int rr = 0; rr < 16; ++rr) mx = fmaxf(mx, S[j][rr]);
    mx = fmaxf(mx, __shfl_xor(mx, 32));
    float l = 0.f;
#pragma unroll
    for (int j = 0; j < 5; ++j)
#pragma unroll
        for (int rr = 0; rr < 16; ++rr) { const float pe = __builtin_amdgcn_exp2f(S[j][rr] - mx); S[j][rr] = pe; l += pe; }
    l += __shfl_xor(l, 32);
    const float inv = 1.f / l;
    if (hi == 0) lse2[((size_t)g * M + rowbase + (size_t)(i0 + ql) * dil) * 8 + h] = mx + __builtin_amdgcn_logf(l);
    f32x16 O0 = {}, O1 = {};
    const int li = lane & 15, gq = li >> 2, gp = li & 3, chh = (lane >> 4) & 1;
#pragma unroll
    for (int j = 0; j < 5; ++j) {
        const int kb = i0 - 128 + 32 * j;
        if (kb >= 0) {
            asm volatile("" ::: "memory");
#pragma unroll
            for (int i = 0; i < 4; ++i) { const int rk = 8 * i + (lane >> 3), ch = lane & 7;
                const u32x4 v = *(const u32x4*)(Vb + (rowbase + (size_t)(kb + rk) * dil) * 1536 + hh * 64 + ch * 8);
                *(LAS u32x4*)(vl + rk * 128 + ch * 16) = v; }
            asm volatile("s_waitcnt lgkmcnt(0)" ::: "memory");
#pragma unroll
            for (int s = 0; s < 2; ++s) {
                u32x4 pw;
                pw.x = pk2(S[j][8 * s + 0] * inv, S[j][8 * s + 1] * inv); pw.y = pk2(S[j][8 * s + 2] * inv, S[j][8 * s + 3] * inv);
                pw.z = pk2(S[j][8 * s + 4] * inv, S[j][8 * s + 5] * inv); pw.w = pk2(S[j][8 * s + 6] * inv, S[j][8 * s + 7] * inv);
                const bf16x8 pa = __builtin_bit_cast(bf16x8, pw);
#pragma unroll
                for (int db = 0; db < 2; ++db) {
                    const LAS unsigned char* a1 = vl + (16 * s + 4 * hi + gq) * 128 + (32 * db + 16 * chh + 4 * gp) * 2;
                    const s16x4 lo = vtr(a1), hv = vtr(a1 + 8 * 128);
                    const bf16x8 vb = {lo[0], lo[1], lo[2], lo[3], hv[0], hv[1], hv[2], hv[3]};
                    if (db == 0) O0 = __builtin_amdgcn_mfma_f32_32x32x16_bf16(pa, vb, O0, 0, 0, 0);
                    else O1 = __builtin_amdgcn_mfma_f32_32x32x16_bf16(pa, vb, O1, 0, 0, 0);
                }
            }
            asm volatile("s_waitcnt lgkmcnt(0)" ::: "memory");
        }
    }
    asm volatile("" ::: "memory");
#pragma unroll
    for (int rr = 0; rr < 16; ++rr) { const int q = crow(rr, hi);
        *(LAS bf16_t*)(vl + q * 128 + ql * 2) = (bf16_t)(pk2(O0[rr], 0.f) & 0xffffu);
        *(LAS bf16_t*)(vl + q * 128 + (32 + ql) * 2) = (bf16_t)(pk2(O1[rr], 0.f) & 0xffffu); }
    asm volatile("s_waitcnt lgkmcnt(0)" ::: "memory");
#pragma unroll
    for (int i = 0; i < 4; ++i) { const int rq = 8 * i + (lane >> 3), ch = lane & 7;
        const u32x4 v = *(const LAS u32x4*)(vl + rq * 128 + ch * 16);
        *(u32x4*)(QK + (rowbase + (size_t)(i0 + rq) * dil) * 3072 + hh * 64 + ch * 8) = v; }
    asm volatile("s_waitcnt lgkmcnt(0)" ::: "memory");
}

__device__ __forceinline__ float transpose_reduce32(float (&a)[32], int lane) {
#pragma unroll
    for (int n = 16; n >= 1; n >>= 1) {
        const bool bit = (lane & n) != 0;
#pragma unroll
        for (int i = 0; i < n; ++i) { const float lo = a[i], hv = a[i + n]; const float send = bit ? lo : hv, keep = bit ? hv : lo; a[i] = keep + __shfl_xor(send, n); }
    }
    return a[0] + __shfl_xor(a[0], 32);
}

__global__ void __launch_bounds__(512, 2) mk_fwd(Args args) {
    extern __shared__ __attribute__((aligned(16))) unsigned char lds_raw[];
    LAS unsigned char* lds = (LAS unsigned char*)lds_raw;
    cg::grid_group grid = cg::this_grid();
    const int tid = threadIdx.x, lane = tid & 63, wave = __builtin_amdgcn_readfirstlane(tid >> 6);
    const int G = gridDim.x, bx = blockIdx.x;
    const int vcu = (G % 8 == 0) ? (bx % 8) * (G / 8) + bx / 8 : bx;
    const int gw = vcu * 8 + wave, NGW = G * 8;
    const int gtid = bx * 512 + tid, NT = G * 512;
    unsigned char* ws = args.ws;
    for (int u = tid; u < (LDS_BYTES - 131072) / 4; u += 512) ((LAS unsigned*)(lds + 131072))[u] = 0u;
    __syncthreads();
    volatile LAS unsigned* MISC = (volatile LAS unsigned*)(lds + 131072 + 320);
    unsigned* ctl = (unsigned*)(ws + WS_CTL);
    const float* x = args.in[0];
    float* out = args.out;
    float* cs = (float*)(ws + WS_CS);
    float* ss = (float*)(ws + WS_SS);
    float* vst = (float*)(ws + WS_VST);
    float* lse2 = (float*)(ws + WS_LSE);
    bf16_t* Win0 = (bf16_t*)(ws + WS_WIN0); bf16_t* Wout0 = (bf16_t*)(ws + WS_WOUT0); bf16_t* W1_0 = (bf16_t*)(ws + WS_W1_0); bf16_t* W2_0 = (bf16_t*)(ws + WS_W2_0);
    bf16_t* Win1 = (bf16_t*)(ws + WS_WIN1); bf16_t* Wout1 = (bf16_t*)(ws + WS_WOUT1); bf16_t* W1_1 = (bf16_t*)(ws + WS_W1_1); bf16_t* W2_1 = (bf16_t*)(ws + WS_W2_1);
    bf16_t* R1 = (bf16_t*)(ws + WS_R1); bf16_t* GLU = (bf16_t*)(ws + WS_GLU); bf16_t* H1B = (bf16_t*)(ws + WS_H1B);
    bf16_t* QK = (bf16_t*)(ws + WS_QK); bf16_t* VB = (bf16_t*)(ws + WS_V); bf16_t* U = (bf16_t*)(ws + WS_U);
    bf16_t* GB = (bf16_t*)(ws + WS_GB); bf16_t* GG = (bf16_t*)(ws + WS_G); bf16_t* UB = (bf16_t*)(ws + WS_UB); bf16_t* VT = (bf16_t*)(ws + WS_VT); bf16_t* MIX1 = (bf16_t*)(ws + WS_MIX1);

    {
        for (int i = gtid; i < 4096; i += NT) ctl[i] = 0u;
        for (int i = gtid; i < 4 * M + 2 * M; i += NT) { if (i < 4 * M) ss[M + i] = 0.f; else vst[i - 4 * M] = 0.f; }
        for (int i = gtid; i < SEQ * 32; i += NT) { const int s = i >> 5, f = i & 31; const float inv = powf(10000.0f, -(float)f / 32.0f); const float ang = (float)s * inv; float sn, c; sincosf(ang, &sn, &c); cs[2 * i] = c; cs[2 * i + 1] = sn; }
        LAS float* scr = (LAS float*)(lds + wave * 16384);
        constexpr int I_IN0 = 16 * (NIN0 / 32), I_OUT = 16 * 32, I_W1 = 16 * (FF / 32), I_W2 = 64 * 32, I_IN1 = 16 * (NIN1 / 32);
        constexpr int NITEMS = I_IN0 + I_OUT + I_W1 + I_W2 + I_IN1 + I_OUT + I_W1 + I_W2;
        for (int it = gw; it < NITEMS; it += NGW) {
            int q = it;
            if (q < I_IN0) { transpose_item<1>(args.in[3], 1024, NIN0, args.in[1], Win0, scr, q, lane); continue; } q -= I_IN0;
            if (q < I_OUT) { transpose_item<0>(args.in[8], 1024, 1024, nullptr, Wout0, scr, q, lane); continue; } q -= I_OUT;
            if (q < I_W1) { transpose_item<0>(args.in[16], 1024, FF, args.in[2], W1_0, scr, q, lane); continue; } q -= I_W1;
            if (q < I_W2) { transpose_item<0>(args.in[17], FF, 1024, nullptr, W2_0, scr, q, lane); continue; } q -= I_W2;
            if (q < I_IN1) { transpose_item<2>(args.in[9], 1024, NIN1, args.in[1] + 1024, Win1, scr, q, lane); continue; } q -= I_IN1;
            if (q < I_OUT) { transpose_item<0>(args.in[15], 1024, 1024, nullptr, Wout1, scr, q, lane); continue; } q -= I_OUT;
            if (q < I_W1) { transpose_item<0>(args.in[16] + (size_t)1024 * FF, 1024, FF, args.in[2] + 1024, W1_1, scr, q, lane); continue; } q -= I_W1;
            transpose_item<0>(args.in[17] + (size_t)FF * 1024, FF, 1024, nullptr, W2_1, scr, q, lane);
        }
        for (int row = gw; row < M; row += NGW) {
            const f32x4* xr = (const f32x4*)(x + (size_t)row * 1024) + lane; float s = 0.f;
            unsigned long long* o8 = (unsigned long long*)(R1 + (size_t)row * 1024) + lane;
#pragma unroll
            for (int j = 0; j < 4; ++j) { const f32x4 v = xr[64 * j]; s += (v[0] * v[0] + v[1] * v[1]) + (v[2] * v[2] + v[3] * v[3]); o8[64 * j] = (unsigned long long)pk2(v[0], v[1]) | ((unsigned long long)pk2(v[2], v[3]) << 32); }
            s = wave_sum(s); if (lane == 0) ss[row] = s;
        }
    }
    grid.sync();
    const XcdBarrier bar = xcd_barrier_post(ctl, MISC + 8);
    {
        pg8::Gemm g{R1, Win0, M, NIN0, 1024}; pg8::StaticOrder S; S.init(M, NIN0, G, bx);
        pg8::EpiP p{}; p.ss = ss; p.o0 = GLU; p.o1 = QK; p.o2 = VB; p.cs = cs;
        pg8::Epi<0> E{p};
        pg8::gemm_phase<pg8::Epi<0>, pg8::StaticOrder, true, true>(lds, g, S, E);
    }
    xcd_barrier(bar);
    {
#ifndef NO_ATTN
        for (int unit = vcu; unit < 256; unit += G) {
            const int b = unit >> 5, h = (unit >> 2) & 7, tb = unit & 3;
            LAS unsigned char* vl = lds + wave * 4096;
            for (int k = 0; k < 6; ++k) {
                const int wu = __builtin_amdgcn_readfirstlane(k * 8 + wave);
                const int g = wu >> 4, e = wu & 15;
                int r, i0;
                if (g == 0) { r = 0; i0 = tb * 512 + 32 * e; }
                else if (g == 1) { r = e & 3; i0 = tb * 128 + 32 * (e >> 2); }
                else { r = e; i0 = tb * 32; }
                attn_wave_unit(QK, VB, lse2, b, g, h, r, i0, vl, lane);
            }
            asm volatile("s_waitcnt vmcnt(0)" ::: "memory");
            __syncthreads();
#pragma unroll 2
            for (int it = 0; it < 8; ++it) {
                const int tl = it * 64 + (tid >> 3), ch = tid & 7; const size_t row = (size_t)b * SEQ + tb * 512 + tl;
                const float l0 = lse2[((size_t)0 * M + row) * 8 + h], l1 = lse2[((size_t)1 * M + row) * 8 + h], l2 = lse2[((size_t)2 * M + row) * 8 + h];
                const float mxl = fmaxf(l0, fmaxf(l1, l2));
                float e0 = __builtin_amdgcn_exp2f(l0 - mxl), e1 = __builtin_amdgcn_exp2f(l1 - mxl), e2 = __builtin_amdgcn_exp2f(l2 - mxl);
                const float inv = 1.f / (e0 + e1 + e2); e0 *= inv; e1 *= inv; e2 *= inv;
                const u32x4 a0 = *(const u32x4*)(QK + row * 3072 + (0 + h) * 64 + ch * 8), a1 = *(const u32x4*)(QK + row * 3072 + (8 + h) * 64 + ch * 8), a2 = *(const u32x4*)(QK + row * 3072 + (16 + h) * 64 + ch * 8);
                u32x4 o;
#pragma unroll
                for (int w = 0; w < 4; ++w) o[w] = pk2(e0 * bflo(a0[w]) + e1 * bflo(a1[w]) + e2 * bflo(a2[w]), e0 * bfhi(a0[w]) + e1 * bfhi(a1[w]) + e2 * bfhi(a2[w]));
                *(u32x4*)(R1 + row * 1024 + 512 + h * 64 + ch * 8) = o;
            }
            __syncthreads();
        }
#endif
#ifndef NO_CONV
        const float* ck = args.in[4]; const float* cb = args.in[5]; const float* lg = args.in[6]; const float* lb = args.in[7];
        LAS float* part = (LAS float*)(lds + 65536); LAS float* stat = (LAS float*)(lds + 65536 + 4096);
        for (int tile = vcu; tile < 512; tile += G) {
            const int t0 = tile * 32, tseq = t0 & 2047;
            for (int idx = tid; idx < 62 * 64; idx += 512) { const int rr = idx >> 6, ch = idx & 63; u32x4 v = {0u, 0u, 0u, 0u};
                if (tseq - 30 + rr >= 0) v = *(const u32x4*)(GLU + (size_t)(t0 - 30 + rr) * 512 + ch * 8);
                *(LAS u32x4*)(lds + rr * 1024 + ch * 16) = v; }
            __syncthreads();
            const int c = tid;
            float o[32];
            {
                float kk[31];
#pragma unroll
                for (int j = 0; j < 31; ++j) kk[j] = ck[j * 512 + c];
                const float bias = cb[c];
#pragma unroll
                for (int t = 0; t < 32; ++t) o[t] = bias;
#pragma unroll
                for (int i = 0; i < 62; ++i) {
                    const float xi = bf2f(*(const LAS bf16_t*)(lds + i * 1024 + c * 2));
#pragma unroll
                    for (int t = 0; t < 32; ++t) if (i - t >= 0 && i - t <= 30) o[t] += kk[i - t] * xi;
                }
            }
            {
                float a[32];
#pragma unroll
                for (int t = 0; t < 32; ++t) a[t] = o[t];
                const float s1 = transpose_reduce32(a, lane);
#pragma unroll
                for (int t = 0; t < 32; ++t) a[t] = o[t] * o[t];
                const float s2 = transpose_reduce32(a, lane);
                if (lane < 32) { part[(lane * 8 + wave) * 2] = s1; part[(lane * 8 + wave) * 2 + 1] = s2; }
            }
            __syncthreads();
            if (tid < 32) { float s1 = 0.f, s2 = 0.f;
#pragma unroll
                for (int w = 0; w < 8; ++w) { s1 += part[(tid * 8 + w) * 2]; s2 += part[(tid * 8 + w) * 2 + 1]; }
                const float mean = s1 * (1.f / 512.f), var = s2 * (1.f / 512.f) - mean * mean;
                stat[2 * tid] = mean; stat[2 * tid + 1] = rsqrtf(fmaxf(var, 0.f) + EPS); }
            __syncthreads();
            const float lgc = lg[c], lbc = lb[c];
#pragma unroll
            for (int t = 0; t < 32; ++t) { const float mean = stat[2 * t], rstd = stat[2 * t + 1]; const float y = (o[t] - mean) * rstd * lgc + lbc; const float a = y * pg8::sigm(y);
                *(LAS bf16_t*)(lds + t * 1024 + c * 2) = (bf16_t)(pk2(a, 0.f) & 0xffffu); }
            __syncthreads();
            for (int idx = tid; idx < 32 * 64; idx += 512) { const int rr = idx >> 6, ch = idx & 63; const u32x4 v = *(const LAS u32x4*)(lds + rr * 1024 + ch * 16); *(u32x4*)(R1 + (size_t)(t0 + rr) * 1024 + ch * 8) = v; }
            __syncthreads();
        }
#endif
    }
    xcd_barrier(bar);
    {
        pg8::Gemm g{R1, Wout0, M, 1024, 1024}; pg8::StaticOrder S; S.init(M, 1024, G, bx);
        pg8::EpiP p{}; p.resid = x; p.hout = out; p.hb = H1B; p.ss_out = ss + M;
        pg8::Epi<1> E{p};
        pg8::gemm_phase<pg8::Epi<1>, pg8::StaticOrder, true, true>(lds, g, S, E);
    }
    xcd_barrier(bar);
    {
        pg8::Gemm g{H1B, W1_0, M, FF, 1024}; pg8::StaticOrder S; S.init(M, FF, G, bx);
        pg8::EpiP p{}; p.ss = ss + M; p.o0 = U;
        pg8::Epi<2> E{p};
        pg8::gemm_phase<pg8::Epi<2>, pg8::StaticOrder, true, true>(lds, g, S, E);
    }
    xcd_barrier(bar);
    {
        pg8::Gemm g{U, W2_0, M, 1024, FF}; pg8::StaticOrder S; S.init(M, 1024, G, bx);
        pg8::EpiP p{}; p.resid = out; p.hout = out; p.hb = R1; p.ss_out = ss + 2 * M;
        pg8::Epi<1> E{p};
        pg8::gemm_phase<pg8::Epi<1>, pg8::StaticOrder, true, true>(lds, g, S, E);
    }
    xcd_barrier(bar);
    {
        pg8::Gemm g{R1, Win1, M, NIN1, 1024}; pg8::StaticOrder S; S.init(M, NIN1, G, bx);
        pg8::EpiP p{}; p.ss = ss + 2 * M; p.o0 = GB; p.o1 = GG; p.o2 = UB; p.o3 = VT; p.vst = vst;
        pg8::Epi<3> E{p};
        pg8::gemm_phase<pg8::Epi<3>, pg8::StaticOrder, true, true>(lds, g, S, E);
    }
    xcd_barrier(bar);
    {
        const float* sk = args.in[10]; const float* lg = args.in[11]; const float* lb = args.in[12]; const float* sgw = args.in[13]; const float* sgb = args.in[14];
        for (int idx = gtid; idx < M * 64; idx += NT) {
            const int row = idx >> 6, ch = idx & 63, tseq = row & 2047;
            const u32x4 gbv = *(const u32x4*)(GB + (size_t)row * 512 + ch * 8);
            float acc[8];
#pragma unroll
            for (int e = 0; e < 8; ++e) acc[e] = 0.f;
#pragma unroll
            for (int j = 0; j < 3; ++j) {
                if (tseq - 2 + j >= 0) {
                    const u32x4 gv = *(const u32x4*)(GG + (size_t)(row - 2 + j) * 512 + ch * 8);
                    const f32x4 k0 = *(const f32x4*)(sk + j * 512 + ch * 8), k1 = *(const f32x4*)(sk + j * 512 + ch * 8 + 4);
                    acc[0] += k0[0] * bflo(gv[0]); acc[1] += k0[1] * bfhi(gv[0]); acc[2] += k0[2] * bflo(gv[1]); acc[3] += k0[3] * bfhi(gv[1]);
                    acc[4] += k1[0] * bflo(gv[2]); acc[5] += k1[1] * bfhi(gv[2]); acc[6] += k1[2] * bflo(gv[3]); acc[7] += k1[3] * bfhi(gv[3]);
                }
            }
            u32x4 o;
#pragma unroll
            for (int w = 0; w < 4; ++w) o[w] = pk2(bflo(gbv[w]) * acc[2 * w], bfhi(gbv[w]) * acc[2 * w + 1]);
            *(u32x4*)(MIX1 + (size_t)row * 1024 + ch * 8) = o;
        }
#ifndef NO_SGU
        LAS float* RS = (LAS float*)lds; LAS float* MU = RS + 128; LAS float* RHO = RS + 256; LAS float* SIG = RS + 384;
        const int ql = lane & 31, hi = lane >> 5;
        for (int unit = vcu; unit < 512; unit += G) {
            const int n = unit >> 2, gi = unit & 3, tok0 = n * 128;
            if (tid < 128) { const float sm = vst[2 * (tok0 + tid)], sq = vst[2 * (tok0 + tid) + 1]; const float mean = sm * (1.f / 512.f), var = sq * (1.f / 512.f) - mean * mean;
                RS[tid] = rsqrtf(fmaxf(var, 0.f) + EPS); MU[tid] = mean; }
            __syncthreads();
            if (tid < 128) { const float* wr_ = sgw + ((size_t)gi * 128 + tid) * 128; float sg = 0.f, rho = 0.f;
                for (int s = 0; s <= tid; ++s) { const float w = wr_[s]; sg += w; rho += w * RS[s] * MU[s]; }
                RHO[tid] = rho; SIG[tid] = sg; }
            const int tr = wave >> 1, tc0 = (wave & 1) * 2;
            f32x16 D0 = {}, D1 = {};
            const int t = 32 * tr + ql;
            const float* wp = sgw + ((size_t)gi * 128 + t) * 128 + 8 * hi;
            const bf16_t* vp0 = VT + ((size_t)gi * 128 + 32 * tc0 + ql) * M + tok0 + 8 * hi;
            const bf16_t* vp1 = vp0 + (size_t)32 * M;
            for (int s0 = 0; s0 < 32 * (tr + 1); s0 += 16) {
                const f32x4 w0 = *(const f32x4*)(wp + s0), w1 = *(const f32x4*)(wp + s0 + 4);
                float av[8];
#pragma unroll
                for (int j = 0; j < 4; ++j) { av[j] = w0[j]; av[j + 4] = w1[j]; }
#pragma unroll
                for (int j = 0; j < 8; ++j) { const int s = s0 + 8 * hi + j; av[j] = (s <= t) ? av[j] * RS[s] : 0.f; }
                u32x4 aw; aw.x = pk2(av[0], av[1]); aw.y = pk2(av[2], av[3]); aw.z = pk2(av[4], av[5]); aw.w = pk2(av[6], av[7]);
                const bf16x8 af = __builtin_bit_cast(bf16x8, aw);
                const bf16x8 b0 = *(const bf16x8*)(vp0 + s0), b1 = *(const bf16x8*)(vp1 + s0);
                D0 = __builtin_amdgcn_mfma_f32_32x32x16_bf16(af, b0, D0, 0, 0, 0);
                D1 = __builtin_amdgcn_mfma_f32_32x32x16_bf16(af, b1, D1, 0, 0, 0);
            }
            __syncthreads();
#pragma unroll
            for (int q = 0; q < 2; ++q) {
                const int chn = gi * 128 + 32 * (tc0 + q) + ql; const float lgc = lg[chn], lbc = lb[chn];
#pragma unroll
                for (int rr = 0; rr < 16; ++rr) { const int tt = 32 * tr + crow(rr, hi); const size_t token = (size_t)tok0 + tt;
                    const float dv = (q == 0) ? D0[rr] : D1[rr];
                    const float val = lgc * (dv - RHO[tt]) + lbc * SIG[tt] + sgb[gi * 128 + tt];
                    const float uu = bf2f(UB[token * 512 + chn]);
                    MIX1[token * 1024 + 512 + chn] = (bf16_t)(pk2(uu * val, 0.f) & 0xffffu); }
            }
            __syncthreads();
        }
#endif
    }
    xcd_barrier(bar);
    {
        pg8::Gemm g{MIX1, Wout1, M, 1024, 1024}; pg8::StaticOrder S; S.init(M, 1024, G, bx);
        pg8::EpiP p{}; p.resid = out; p.hout = out; p.hb = R1; p.ss_out = ss + 3 * M;
        pg8::Epi<1> E{p};
        pg8::gemm_phase<pg8::Epi<1>, pg8::StaticOrder, true, true>(lds, g, S, E);
    }
    xcd_barrier(bar);
    {
        pg8::Gemm g{R1, W1_1, M, FF, 1024}; pg8::StaticOrder S; S.init(M, FF, G, bx);
        pg8::EpiP p{}; p.ss = ss + 3 * M; p.o0 = U;
        pg8::Epi<2> E{p};
        pg8::gemm_phase<pg8::Epi<2>, pg8::StaticOrder, true, true>(lds, g, S, E);
    }
    xcd_barrier(bar);
    {
        pg8::Gemm g{U, W2_1, M, 1024, FF}; pg8::StaticOrder S; S.init(M, 1024, G, bx);
        pg8::EpiP p{}; p.resid = out; p.hout = out; p.hb = nullptr; p.ss_out = ss + 4 * M;
        pg8::Epi<1> E{p};
        pg8::gemm_phase<pg8::Epi<1>, pg8::StaticOrder, true, true>(lds, g, S, E);
    }
    xcd_barrier(bar);
    {
        const float* fg = args.in[18];
        for (int row = gw; row < M; row += NGW) {
            const float r = rsqrtf(ss[4 * M + row] * (1.f / 1024.f) + EPS);
            f32x4* orow = (f32x4*)(out + (size_t)row * 1024) + lane; const f32x4* gr = (const f32x4*)fg + lane;
#pragma unroll
            for (int j = 0; j < 4; ++j) { const f32x4 v = orow[64 * j]; orow[64 * j] = v * r * gr[64 * j]; }
        }
    }
}

extern "C" void kernel_launch(void* const* d_in, const int* in_sizes, int n_in, void* d_out, int out_size, void* d_ws, size_t ws_size, hipStream_t stream) {
    static int grid = 0;
    if (grid == 0) {
        if (n_in != 19 || out_size != M * DM || ws_size < WS_END) { fprintf(stderr, "kernel_launch: unexpected shapes (n_in %d out %d ws %zu)\n", n_in, out_size, ws_size); grid = -1; return; }
        int dev = 0, cus = 0, per_cu = 0;
        hipGetDevice(&dev); hipDeviceGetAttribute(&cus, hipDeviceAttributeMultiprocessorCount, dev);
        if (hipFuncSetAttribute((const void*)mk_fwd, hipFuncAttributeMaxDynamicSharedMemorySize, LDS_BYTES) != hipSuccess) { fprintf(stderr, "kernel_launch: hipFuncSetAttribute failed\n"); grid = -1; return; }
        if (hipOccupancyMaxActiveBlocksPerMultiprocessor(&per_cu, (const void*)mk_fwd, 512, LDS_BYTES) != hipSuccess || per_cu < 1) { fprintf(stderr, "kernel_launch: occupancy query says %d\n", per_cu); per_cu = 1; }
        (void)hipGetLastError();
        grid = cus;
        fprintf(stderr, "kernel_launch: cus %d per_cu %d grid %d\n", cus, per_cu, grid);
    }
    if (grid < 0) return;
    Args a{};
    for (int i = 0; i < 19; ++i) a.in[i] = (const float*)d_in[i];
    a.out = (float*)d_out; a.ws = (unsigned char*)d_ws;
    void* kargs[] = {&a};
    hipError_t e = hipLaunchCooperativeKernel((const void*)mk_fwd, dim3(grid), dim3(512), kargs, LDS_BYTES, stream);
    if (e != hipSuccess) fprintf(stderr, "cooperative launch failed: %s (grid %d)\n", hipGetErrorString(e), grid);
}
```

```cpp
#include <hip/hip_runtime.h>
#include <hip/hip_cooperative_groups.h>
#include <cstdio>
#include <cstdint>
namespace cg = cooperative_groups;

#ifndef MK_CHECK
#define MK_CHECK 0
#endif

constexpr int M = 16384, DM = 1024, SEQ = 2048, NIN0 = 5632, NIN1 = 2560, FF = 4096;
constexpr float EPS = 1e-6f;
constexpr float QSCALE = 0.125f * 1.4426950408889634f;
constexpr size_t MiB = 1u << 20;
constexpr size_t WS_CTL = 0;
constexpr size_t WS_CS = 1 * MiB;
constexpr size_t WS_SS = WS_CS + 512 * 1024;
constexpr size_t WS_VST = WS_SS + 5 * M * 4;
constexpr size_t WS_CKT = WS_VST + 2 * M * 4;
constexpr size_t WS_LSE = 2 * MiB;
constexpr size_t WS_W = 4 * MiB;
constexpr size_t WS_WIN0 = WS_W, WS_WOUT0 = WS_WIN0 + 11 * MiB, WS_W1_0 = WS_WOUT0 + 2 * MiB, WS_W2_0 = WS_W1_0 + 8 * MiB;
constexpr size_t WS_WIN1 = WS_W2_0 + 8 * MiB, WS_WOUT1 = WS_WIN1 + 5 * MiB, WS_W1_1 = WS_WOUT1 + 2 * MiB, WS_W2_1 = WS_W1_1 + 8 * MiB;
constexpr size_t WS_R1 = 56 * MiB;
constexpr size_t WS_GLU = 88 * MiB;
constexpr size_t WS_H1B = 88 * MiB;
constexpr size_t WS_QK = 104 * MiB;
constexpr size_t WS_V = 200 * MiB;
constexpr size_t WS_U = 120 * MiB;
constexpr size_t WS_GB = 88 * MiB, WS_G = 104 * MiB, WS_UB = 120 * MiB, WS_VT = 136 * MiB, WS_MIX1 = 152 * MiB;
constexpr size_t WS_END = 248 * MiB;
static_assert(WS_W2_1 + 8 * MiB == WS_R1, "weights end at R1");
constexpr int LDS_BYTES = 147456;

namespace pg8 {
#define PG8_LAS __attribute__((address_space(3)))
typedef unsigned short bf16_t;
typedef short bf16x8 __attribute__((ext_vector_type(8)));
typedef float f32x4 __attribute__((ext_vector_type(4)));
typedef unsigned u32x4 __attribute__((ext_vector_type(4)));
constexpr int BM = 256, BK = 64, HALF = 128, HTB = HALF * BK * 2  , STAGE_BYTES = 8 * HTB, NXCD = 8, WGM = 8;

__host__ __device__ __forceinline__ int lds_byte(int r, int c) { const int st = (r >> 4) * 2 + (c >> 5), rr = r & 15, cc = c & 31, ob = rr * 64 + cc * 2; return st * 1024 + (ob ^ (((ob >> 9) & 1) << 5)); }
__host__ __device__ __forceinline__ void stage_rc(int b, int& R, int& C) { const int st = b / 1024, sb = b % 1024, swz = sb ^ (((sb >> 9) & 1) << 5); R = (st >> 1) * 16 + swz / 64; C = (st & 1) * 32 + (swz % 64) / 2; }
__host__ __device__ __forceinline__ int perm32(int rho) { const int n = rho >> 4, i = rho & 15; return 8 * (i >> 2) + 4 * n + (i & 3); }

struct Unit { int pm, pn; };
struct Gemm { const bf16_t* A; const bf16_t* Bt; int M, N, K; };

struct StaticOrder {
    int nM, nN, nwg, G, c;
    __host__ __device__ void init(int M, int N, int G_, int c_) { nM = M / BM; nN = N / BM; nwg = nM * nN; G = G_; c = c_; }
    __host__ __device__ bool next(int i, Unit& u) const {
        const long L = (long)i * G + c; if (L >= nwg) return false;
        int wgid = (int)L; { const int q = nwg / NXCD, r = nwg % NXCD, xcd = wgid % NXCD, off = wgid / NXCD; wgid = (xcd < r ? xcd * (q + 1) : r * (q + 1) + (xcd - r) * q) + off; }
        const int nig = WGM * nN, gid = wgid / nig, fm = gid * WGM, gsz = (nM - fm) < WGM ? (nM - fm) : WGM;
        u.pm = fm + ((wgid % nig) % gsz); u.pn = (wgid % nig) / gsz; return true;
    }
    __device__ __forceinline__ void a_ready(const Unit&) const {}
    __device__ __forceinline__ void done(const Unit&) const {}
};

__device__ __forceinline__ unsigned cvt_pk_bf16(float lo, float hi) { unsigned r; asm volatile("v_cvt_pk_bf16_f32 %0, %1, %2" : "=v"(r) : "v"(lo), "v"(hi)); return r; }
typedef float f32x2 __attribute__((ext_vector_type(2)));
typedef unsigned u32x2 __attribute__((ext_vector_type(2)));
__device__ __forceinline__ void store8(bf16_t* p, const f32x4& a, const f32x4& b) { u32x4 w; w.x = cvt_pk_bf16(a[0], a[1]); w.y = cvt_pk_bf16(a[2], a[3]); w.z = cvt_pk_bf16(b[0], b[1]); w.w = cvt_pk_bf16(b[2], b[3]); *(u32x4*)p = w; }
__device__ __forceinline__ void store4(bf16_t* p, const f32x4& a) { u32x2 w; w.x = cvt_pk_bf16(a[0], a[1]); w.y = cvt_pk_bf16(a[2], a[3]); *(u32x2*)p = w; }
__device__ __forceinline__ float sigm(float x) { return __builtin_amdgcn_rcpf(1.f + __expf(-x)); }
__device__ __forceinline__ float gelu_t(float x) { const float t = 1.5957691216057308f * (x + 0.044715f * x * x * x); return x * sigm(t); }
struct EpiP {
    const float* ss; float* ss_out; const float* resid; float* hout; bf16_t* hb;
    bf16_t* o0; bf16_t* o1; bf16_t* o2; bf16_t* o3; const float* cs; float* vst;
};
template <int KIND> struct Epi {
    static constexpr bool PERM = true, AFTER_DRAIN = false;
    EpiP p;
    __device__ __forceinline__ void operator()(const f32x4 (&acc)[2][2][4][2], const Unit& u, int wr, int wc, int fr, int fq) const {
        const int colt = u.pn * BM + wc * 32 + 8 * fq;
#pragma unroll
        for (int ai = 0; ai < 2; ++ai)
#pragma unroll
            for (int m = 0; m < 4; ++m) {
                const int row = u.pm * BM + ai * HALF + wr * 64 + m * 16 + fr;
                float r = 1.f;
                if (KIND != 1) r = rsqrtf(p.ss[row] * (1.f / 1024.f) + 1e-6f);
                float sq = 0.f, s1 = 0.f;
#pragma unroll
                for (int bj = 0; bj < 2; ++bj) {
                    const int c0 = colt + bj * HALF;
                    f32x4 v0 = acc[ai][bj][m][0] * r, v1 = acc[ai][bj][m][1] * r;
                    if (KIND == 0) {
                        if (u.pn < 4) {
                            f32x4 o;
#pragma unroll
                            for (int j = 0; j < 4; ++j) o[j] = v0[j] * sigm(v1[j]);
                            store4(p.o0 + (size_t)row * 512 + (c0 >> 1), o);
                        } else if (u.pn < 16) {
                            const int qq = ((c0 - 1024) & 63) >> 3, pos = row & 2047;
                            const f32x4* t = (const f32x4*)(p.cs + ((size_t)pos * 32 + 4 * qq) * 2);
                            const f32x4 t0 = t[0], t1 = t[1];
                            const f32x4 cc = {t0[0], t0[2], t1[0], t1[2]}, sn = {t0[1], t0[3], t1[1], t1[3]};
                            f32x4 o1 = v0 * cc - v1 * sn, o2 = v1 * cc + v0 * sn;
                            if (u.pn < 10) { o1 = o1 * QSCALE; o2 = o2 * QSCALE; }
                            store8(p.o1 + (size_t)row * 3072 + (c0 - 1024), o1, o2);
                        } else {
                            store8(p.o2 + (size_t)row * 1536 + (c0 - 4096), v0, v1);
                        }
                    } else if (KIND == 1) {
                        const size_t off = (size_t)row * 1024 + c0;
                        const f32x4 r0 = *(const f32x4*)(p.resid + off), r1 = *(const f32x4*)(p.resid + off + 4);
                        v0 = v0 + r0; v1 = v1 + r1;
                        *(f32x4*)(p.hout + off) = v0; *(f32x4*)(p.hout + off + 4) = v1;
                        if (p.hb) store8(p.hb + off, v0, v1);
#pragma unroll
                        for (int j = 0; j < 4; ++j) sq += v0[j] * v0[j] + v1[j] * v1[j];
                    } else if (KIND == 2) {
#pragma unroll
                        for (int j = 0; j < 4; ++j) { float a = fmaxf(v0[j], 0.f), b = fmaxf(v1[j], 0.f); v0[j] = a * a; v1[j] = b * b; }
                        store8(p.o0 + (size_t)row * 4096 + c0, v0, v1);
                    } else {
                        if (u.pn < 2) store8(p.o0 + (size_t)row * 512 + c0, v0, v1);
                        else if (u.pn < 6) { const f32x4 o = v0 * v1; store4(p.o1 + (size_t)row * 512 + ((c0 - 512) >> 1), o); }
                        else if (u.pn < 8) {
#pragma unroll
                            for (int j = 0; j < 4; ++j) { v0[j] = gelu_t(v0[j]); v1[j] = gelu_t(v1[j]); }
                            store8(p.o2 + (size_t)row * 512 + (c0 - 1536), v0, v1);
                        } else {
                            bf16_t* vt = p.o3 + (size_t)(c0 - 2048) * ::M + row;
#pragma unroll
                            for (int j = 0; j < 4; ++j) { v0[j] = gelu_t(v0[j]); v1[j] = gelu_t(v1[j]); s1 += v0[j] + v1[j]; sq += v0[j] * v0[j] + v1[j] * v1[j]; }
#pragma unroll
                            for (int j = 0; j < 4; ++j) { vt[(size_t)j * ::M] = (bf16_t)(cvt_pk_bf16(v0[j], 0.f) & 0xffffu); vt[(size_t)(j + 4) * ::M] = (bf16_t)(cvt_pk_bf16(v1[j], 0.f) & 0xffffu); }
                        }
                    }
                }
                if (KIND == 1) {
                    sq += __shfl_xor(sq, 16); sq += __shfl_xor(sq, 32);
                    if (fq == 0) atomicAdd(p.ss_out + row, sq);
                }
                if (KIND == 3) {
                    if (u.pn >= 8) {
                        sq += __shfl_xor(sq, 16); sq += __shfl_xor(sq, 32); s1 += __shfl_xor(s1, 16); s1 += __shfl_xor(s1, 32);
                        if (fq == 0) { atomicAdd(p.vst + 2 * row, s1); atomicAdd(p.vst + 2 * row + 1, sq); }
                    }
                }
            }
    }
};
template <class Epi, class Sched, bool ALIGN_EPI = false, bool SP2 = false>
__device__ __forceinline__ void gemm_phase(PG8_LAS unsigned char* lds, const Gemm g, const Sched& S, const Epi& E) {
    int tid_ = threadIdx.x; asm volatile("" : "+v"(tid_));
    const int tid = tid_, wid = __builtin_amdgcn_readfirstlane(tid >> 6), lane = tid & 63, wr = wid >> 2, wc = wid & 3, fr = lane & 15, fq = lane >> 4;
    const int K = g.K, nt = K / BK;
    unsigned voffA[2], voffB[2];
#pragma unroll
    for (int i = 0; i < 2; ++i) { int R, C; stage_rc(tid * 16 + i * 8192, R, C); const int Rb = Epi::PERM ? ((R & ~31) + perm32(R & 31)) : R;
        voffA[i] = (unsigned)(R * K + C) * 2u; voffB[i] = (unsigned)(Rb * K + C) * 2u; }
    const size_t kstep = (size_t)(BK * 2);
    const size_t hstep = (size_t)HALF * K * 2;
    const size_t tstep = 2 * hstep;
    const unsigned ldsw = (unsigned)wid * 1024u;
    const int aoff = lds_byte(wr * 64 + fr, fq * 8), boff = lds_byte(wc * 32 + fr, fq * 8);
#define PG8_SA(b, h) (((b) * 2 + (h)) * HTB)
#define PG8_SB(b, h) ((4 + (b) * 2 + (h)) * HTB)
#define PG8_STAGE(bufoff, gbase, voff) do { _Pragma("unroll") for (int _i = 0; _i < 2; ++_i) \
        __builtin_amdgcn_global_load_lds((const unsigned*)((const char*)(gbase) + (voff)[_i]), (PG8_LAS unsigned*)(lds + (bufoff) + ldsw + _i * 8192), 16, 0, 0); } while (0)
#define PG8_LDA(dst, b, h) do { _Pragma("unroll") for (int m = 0; m < 4; ++m) _Pragma("unroll") for (int k = 0; k < 2; ++k) dst[m][k] = *(const PG8_LAS bf16x8*)(lds + PG8_SA(b, h) + aoff + m * 2048 + k * 1024); } while (0)
#define PG8_LDB(dst, b, h) do { _Pragma("unroll") for (int n = 0; n < 2; ++n) _Pragma("unroll") for (int k = 0; k < 2; ++k) dst[n][k] = *(const PG8_LAS bf16x8*)(lds + PG8_SB(b, h) + boff + n * 2048 + k * 1024); } while (0)
#define PG8_MMA(ai, bj, At, Bt) do { __builtin_amdgcn_s_setprio(1); _Pragma("unroll") for (int m = 0; m < 4; ++m) _Pragma("unroll") for (int n = 0; n < 2; ++n) _Pragma("unroll") for (int k = 0; k < 2; ++k) \
        acc[ai][bj][m][n] = __builtin_amdgcn_mfma_f32_16x16x32_bf16(Bt[n][k], At[m][k], acc[ai][bj][m][n], 0, 0, 0); __builtin_amdgcn_s_setprio(0); } while (0)
#define PG8_WAIT_V(n) asm volatile("s_waitcnt vmcnt(" #n ")" ::: "memory")
#define PG8_WAIT_L(n) asm volatile("s_waitcnt lgkmcnt(" #n ")" ::: "memory")
#define PG8_BAR __builtin_amdgcn_s_barrier()
#define PG8_SCHED __builtin_amdgcn_sched_barrier(0)
    Unit cur, nxt; int ui = 0;
    if (!S.next(0, cur)) return;
    f32x4 acc[2][2][4][2];
#pragma unroll
    for (int a = 0; a < 2; ++a)
#pragma unroll
        for (int b = 0; b < 2; ++b)
#pragma unroll
            for (int m = 0; m < 4; ++m)
#pragma unroll
                for (int n = 0; n < 2; ++n) acc[a][b][m][n] = (f32x4){0.f, 0.f, 0.f, 0.f};
    bf16x8 At[4][2], B0[2][2], B1[2][2];
    const char* cA = (const char*)g.A + (size_t)cur.pm * tstep; const char* cB = (const char*)g.Bt + (size_t)cur.pn * tstep;
    S.a_ready(cur);
    if constexpr (SP2) {
        PG8_STAGE(PG8_SB(0, 0), cB, voffB); PG8_STAGE(PG8_SB(0, 1), cB + hstep, voffB); PG8_STAGE(PG8_SA(0, 0), cA, voffA); PG8_STAGE(PG8_SA(0, 1), cA + hstep, voffA);
        if (wr == 1) PG8_BAR;
        PG8_WAIT_V(2); PG8_BAR;
        PG8_STAGE(PG8_SB(1, 0), cB + kstep, voffB); PG8_STAGE(PG8_SA(1, 0), cA + kstep, voffA); PG8_STAGE(PG8_SB(1, 1), cB + hstep + kstep, voffB);
        PG8_WAIT_V(6); PG8_BAR;
    } else {
        PG8_STAGE(PG8_SB(0, 0), cB, voffB); PG8_STAGE(PG8_SA(0, 0), cA, voffA); PG8_STAGE(PG8_SB(0, 1), cB + hstep, voffB); PG8_STAGE(PG8_SA(0, 1), cA + hstep, voffA);
        if (wr == 1) PG8_BAR;
        PG8_WAIT_V(4); PG8_BAR;
        PG8_STAGE(PG8_SB(1, 0), cB + kstep, voffB); PG8_STAGE(PG8_SA(1, 0), cA + kstep, voffA); PG8_STAGE(PG8_SB(1, 1), cB + hstep + kstep, voffB);
        PG8_WAIT_V(6); PG8_BAR;
    }
    for (;;) {
        const bool has_next = S.next(ui + 1, nxt);
        const char* nA = has_next ? (const char*)g.A + (size_t)nxt.pm * tstep : cA; const char* nB = has_next ? (const char*)g.Bt + (size_t)nxt.pn * tstep : cB;
        for (int t = 0; t < nt; t += 2) {
            const bool last = (t == nt - 2);
            const char* a1 = cA + (size_t)(t + 1) * kstep;
            const char* a2 = last ? nA : cA + (size_t)(t + 2) * kstep; const char* b2 = last ? nB : cB + (size_t)(t + 2) * kstep;
            const char* a3 = a2 + kstep; const char* b3 = b2 + kstep;
            if (last && has_next) S.a_ready(nxt);
            if constexpr (SP2) {
            PG8_LDB(B0, 0, 0); PG8_LDB(B1, 0, 1); PG8_SCHED; PG8_LDA(At, 0, 0); PG8_STAGE(PG8_SA(1, 1), a1 + hstep, voffA);
            PG8_WAIT_V(8); PG8_WAIT_L(0); PG8_BAR; PG8_MMA(0, 0, At, B0); PG8_MMA(0, 1, At, B1); PG8_BAR; PG8_SCHED;
            PG8_LDA(At, 0, 1); PG8_STAGE(PG8_SB(0, 0), b2, voffB); PG8_STAGE(PG8_SB(0, 1), b2 + hstep, voffB); PG8_STAGE(PG8_SA(0, 0), a2, voffA);
            PG8_WAIT_V(8); PG8_WAIT_L(0); PG8_BAR; PG8_MMA(1, 0, At, B0); PG8_MMA(1, 1, At, B1); PG8_BAR; PG8_SCHED;
            PG8_LDB(B0, 1, 0); PG8_LDB(B1, 1, 1); PG8_SCHED; PG8_LDA(At, 1, 0); PG8_STAGE(PG8_SA(0, 1), a2 + hstep, voffA);
            PG8_WAIT_V(8); PG8_WAIT_L(0); PG8_BAR; PG8_MMA(0, 0, At, B0); PG8_MMA(0, 1, At, B1); PG8_BAR; PG8_SCHED;
            PG8_LDA(At, 1, 1); PG8_STAGE(PG8_SB(1, 0), b3, voffB); PG8_STAGE(PG8_SB(1, 1), b3 + hstep, voffB); PG8_STAGE(PG8_SA(1, 0), a3, voffA);
            PG8_WAIT_V(8); PG8_WAIT_L(0); PG8_BAR; PG8_MMA(1, 0, At, B0); PG8_MMA(1, 1, At, B1); PG8_BAR; PG8_SCHED;
            } else {
            PG8_LDB(B0, 0, 0); PG8_SCHED; PG8_LDA(At, 0, 0); PG8_STAGE(PG8_SA(1, 1), a1 + hstep, voffA);
            PG8_WAIT_L(8); PG8_BAR; PG8_WAIT_L(0); PG8_MMA(0, 0, At, B0); PG8_BAR; PG8_SCHED;
            PG8_LDB(B1, 0, 1); PG8_STAGE(PG8_SB(0, 0), b2, voffB);
            PG8_BAR; PG8_WAIT_L(0); PG8_MMA(0, 1, At, B1); PG8_BAR;
            PG8_LDA(At, 0, 1); PG8_STAGE(PG8_SA(0, 0), a2, voffA);
            PG8_BAR; PG8_WAIT_L(0); PG8_MMA(1, 0, At, B0); PG8_BAR; PG8_SCHED;
            PG8_STAGE(PG8_SB(0, 1), b2 + hstep, voffB);
            PG8_WAIT_V(6); PG8_BAR; PG8_MMA(1, 1, At, B1); PG8_BAR;
            PG8_LDB(B0, 1, 0); PG8_SCHED; PG8_LDA(At, 1, 0); PG8_STAGE(PG8_SA(0, 1), a2 + hstep, voffA);
            PG8_WAIT_L(8); PG8_BAR; PG8_WAIT_L(0); PG8_MMA(0, 0, At, B0); PG8_BAR; PG8_SCHED;
            PG8_LDB(B1, 1, 1); PG8_STAGE(PG8_SB(1, 0), b3, voffB);
            PG8_BAR; PG8_WAIT_L(0); PG8_MMA(0, 1, At, B1); PG8_BAR;
            PG8_LDA(At, 1, 1); PG8_STAGE(PG8_SA(1, 0), a3, voffA);
            PG8_BAR; PG8_WAIT_L(0); PG8_MMA(1, 0, At, B0); PG8_BAR; PG8_SCHED;
            PG8_STAGE(PG8_SB(1, 1), b3 + hstep, voffB);
            PG8_WAIT_V(6); PG8_BAR; PG8_MMA(1, 1, At, B1); PG8_BAR;
            }
        }
        if constexpr (ALIGN_EPI) { if (wr == 0) PG8_BAR; }
        if constexpr (!Epi::AFTER_DRAIN) { E(acc, cur, wr, wc, fr, fq); S.done(cur); }
        if (!has_next) break;
#pragma unroll
        for (int a = 0; a < 2; ++a)
#pragma unroll
            for (int b = 0; b < 2; ++b)
#pragma unroll
                for (int m = 0; m < 4; ++m)
#pragma unroll
                    for (int n = 0; n < 2; ++n) acc[a][b][m][n] = (f32x4){0.f, 0.f, 0.f, 0.f};
        cur = nxt; cA = nA; cB = nB; ++ui;
        if constexpr (ALIGN_EPI) { if (wr == 1) PG8_BAR; }
    }
    PG8_WAIT_V(0);
    if constexpr (!ALIGN_EPI) { if (wr == 0) PG8_BAR; }
    PG8_BAR;
    if constexpr (Epi::AFTER_DRAIN) { E.fused(acc, cur, wr, wc, fr, fq, lds, wid, lane); S.done(cur); }
#undef PG8_SA
#undef PG8_SB
#undef PG8_STAGE
#undef PG8_LDA
#undef PG8_LDB
#undef PG8_MMA
#undef PG8_WAIT_V
#undef PG8_WAIT_L
#undef PG8_BAR
#undef PG8_SCHED
}
}
#define LAS __attribute__((address_space(3)))
typedef unsigned short bf16_t;
typedef short bf16x8 __attribute__((ext_vector_type(8)));
typedef short s16x4 __attribute__((ext_vector_type(4)));
typedef float f32x4 __attribute__((ext_vector_type(4)));
typedef float f32x16 __attribute__((ext_vector_type(16)));
typedef unsigned u32x4 __attribute__((ext_vector_type(4)));
typedef float f32x2_t __attribute__((ext_vector_type(2)));
typedef __bf16 bf16x2_t __attribute__((ext_vector_type(2)));
__device__ __forceinline__ unsigned pk2(float lo, float hi) { f32x2_t v = {lo, hi}; bf16x2_t b = __builtin_convertvector(v, bf16x2_t); return __builtin_bit_cast(unsigned, b); }
__device__ __forceinline__ float bf2f(unsigned short x) { return __uint_as_float((unsigned)x << 16); }
__device__ __forceinline__ float bflo(unsigned w) { return __uint_as_float(w << 16); }
__device__ __forceinline__ float bfhi(unsigned w) { return __uint_as_float(w & 0xffff0000u); }
__device__ __forceinline__ int crow(int r, int hi) { return (r & 3) + 8 * (r >> 2) + 4 * hi; }
__device__ __forceinline__ float wave_sum(float v) {
#pragma unroll
    for (int o = 1; o < 64; o <<= 1) v += __shfl_xor(v, o);
    return v;
}

#define GAS __attribute__((address_space(1)))
#define XB_TMO      128
#define XB_XCNT(j)  (256  + 64 * (j))
#define XB_XSUB(j)  (1280 + 64 * (j))
#define XB_XGEN(j)  (2304 + 64 * (j))
#define XB_TOP      3328
#define XB_TOPGEN   3392
#define XCD_BAR_WORDS 3456
#define XB_SPIN_CAP (1u << 18)

__device__ __forceinline__ unsigned xb_ld(unsigned* p)              { return __hip_atomic_load(p, __ATOMIC_RELAXED, __HIP_MEMORY_SCOPE_AGENT); }
__device__ __forceinline__ unsigned xb_add(unsigned* p, unsigned v) { return __hip_atomic_fetch_add(p, v, __ATOMIC_RELAXED, __HIP_MEMORY_SCOPE_AGENT); }
__device__ __forceinline__ unsigned xb_xcc_id() { return (unsigned)__builtin_amdgcn_s_getreg((3 << 11) | 20) & 0xFu; }
#define XB_SPIN(cond, bar) do { unsigned _sp = 0; while (cond) { __builtin_amdgcn_s_sleep(1); \
    if ((++_sp & 255u) == 0u) { if (xb_ld(&(bar)[XB_TMO])) break; if (_sp > XB_SPIN_CAP) { atomicAdd(&(bar)[XB_TMO], 1u); break; } } } } while (0)

struct XcdBarrier {
    unsigned* bar; unsigned x;
    volatile LAS unsigned* st;
};

__device__ __forceinline__ XcdBarrier xcd_barrier_post(unsigned* bar, volatile LAS unsigned* st) {
    XcdBarrier b; b.bar = bar; b.x = xb_xcc_id(); b.st = st;
    if (threadIdx.x == 0) (void)xb_add(&bar[XB_XCNT(b.x)], 1u);
    return b;
}
__device__ __forceinline__ void xcd_barrier_complete(unsigned* bar, unsigned x, unsigned& nloc, unsigned& nx) {
    const unsigned G = gridDim.x * gridDim.y * gridDim.z;
    unsigned sum, cnt, mine, sp = 0u;
    for (;;) {
        sum = 0u; cnt = 0u; mine = 0u;
#pragma unroll
        for (unsigned j = 0; j < 16; ++j) { const unsigned c = xb_ld(&bar[XB_XCNT(j)]); sum += c; cnt += (c > 0u) ? 1u : 0u; mine = (j == x) ? c : mine; }
        if (sum == G) break;
        __builtin_amdgcn_s_sleep(1);
        if ((++sp & 255u) == 0u) { if (xb_ld(&bar[XB_TMO])) break; if (sp > XB_SPIN_CAP) { atomicAdd(&bar[XB_TMO], 1u); break; } }
    }
    nloc = mine > 0u ? mine : 1u; nx = cnt > 0u ? cnt : 1u;
}

__device__ __forceinline__ void xcd_barrier(const XcdBarrier& b) {
    asm volatile("s_waitcnt vmcnt(0)" ::: "memory");
    __syncthreads();
    if (threadIdx.x == 0) {
        unsigned* bar = b.bar;
        __builtin_amdgcn_s_waitcnt(0);
        unsigned nloc = b.st[0], nx = b.st[1];
        if (nloc == 0u) { xcd_barrier_complete(bar, b.x, nloc, nx); b.st[0] = nloc; b.st[1] = nx; }
        const unsigned old = xb_add(&bar[XB_XSUB(b.x)], 1u);
        const unsigned gen = old / nloc;
        if (old + 1u == (gen + 1u) * nloc) {
            __builtin_amdgcn_fence(__ATOMIC_RELEASE, "agent");
            asm volatile("s_waitcnt vmcnt(0)" ::: "memory");
            const unsigned og = xb_add(&bar[XB_TOP], 1u);
            const unsigned tg = og / nx;
            if (og + 1u == (tg + 1u) * nx) xb_add(&bar[XB_TOPGEN], 1u);
            else XB_SPIN(xb_ld(&bar[XB_TOPGEN]) == tg, bar);
            __builtin_amdgcn_fence(__ATOMIC_ACQUIRE, "agent");
            xb_add(&bar[XB_XGEN(b.x)], 1u);
            asm volatile("s_waitcnt vmcnt(0)" ::: "memory");
        } else {
            XB_SPIN(xb_ld(&bar[XB_XGEN(b.x)]) == gen, bar);
            __builtin_amdgcn_fence(__ATOMIC_ACQUIRE, "agent");
            asm volatile("s_waitcnt vmcnt(0)" ::: "memory");
        }
    }
    __syncthreads();
}

struct Args { const float* in[19]; float* out; unsigned char* ws; };

__device__ __forceinline__ int perm_in0(int n) {
    if (n < 1024) { const int q8 = n >> 3, e = n & 7; return (e < 4) ? (4 * q8 + e) : (512 + 4 * q8 + (e - 4)); }
    if (n < 4096) { const int w = (n - 1024) & 63, hh = (n - 1024) >> 6, qq = w >> 3, e = w & 7; return 1024 + 64 * hh + 4 * qq + (e & 3) + ((e >= 4) ? 32 : 0); }
    return n;
}
__device__ __forceinline__ int perm_in1(int n) {
    if (n >= 512 && n < 1536) { const int mm = n - 512, q8 = mm >> 3, e = mm & 7; return (e < 4) ? (512 + 4 * q8 + e) : (1024 + 4 * q8 + (e - 4)); }
    return n;
}
template <int PERM>
__device__ __forceinline__ void transpose_item(const float* W, int K, int N, const float* kscale, bf16_t* WT, LAS float* scr, int item, int lane) {
    const int nblk = N / 32, kb = item / nblk, nb = item % nblk, k0 = 64 * kb, n0 = 32 * nb;
    const int nd = n0 + (lane & 31);
    const int ns = (PERM == 1) ? perm_in0(nd) : (PERM == 2) ? perm_in1(nd) : nd;
#pragma unroll 8
    for (int i = 0; i < 32; ++i) { const int kk = 2 * i + (lane >> 5); float w = W[(size_t)(k0 + kk) * N + ns]; if (kscale) w *= kscale[k0 + kk]; scr[kk * 33 + (lane & 31)] = w; }
    asm volatile("s_waitcnt lgkmcnt(0)" ::: "memory");
    const int c = lane & 7;
#pragma unroll
    for (int j = 0; j < 4; ++j) { const int n = (lane >> 3) + 8 * j; const LAS float* s = scr + (8 * c) * 33 + n;
        u32x4 o; o.x = pk2(s[0 * 33], s[1 * 33]); o.y = pk2(s[2 * 33], s[3 * 33]); o.z = pk2(s[4 * 33], s[5 * 33]); o.w = pk2(s[6 * 33], s[7 * 33]);
        *(u32x4*)(WT + (size_t)(n0 + n) * K + k0 + 8 * c) = o; }
    asm volatile("s_waitcnt lgkmcnt(0)" ::: "memory");
}

__device__ __forceinline__ s16x4 vtr(const LAS unsigned char* p) { typedef short v4i16_t __attribute__((ext_vector_type(4))); return __builtin_bit_cast(s16x4, __builtin_amdgcn_ds_read_tr16_b64_v4i16((LAS v4i16_t*)p)); }
__device__ __forceinline__ void attn_wave_unit(bf16_t* QK, const bf16_t* Vb, float* lse2, int b, int g, int h, int r, int i0, LAS unsigned char* vl, int lane) {
    const int dil = (g == 0) ? 1 : (g == 1 ? 4 : 16);
    const int hh = g * 8 + h, ql = lane & 31, hi = lane >> 5;
    const size_t rowbase = (size_t)b * SEQ + r;
    const bf16_t* qp = QK + (rowbase + (size_t)(i0 + ql) * dil) * 3072 + hh * 64 + hi * 8;
    bf16x8 qf[4];
#pragma unroll
    for (int s = 0; s < 4; ++s) qf[s] = *(const bf16x8*)(qp + 16 * s);
    bf16x8 kf[5][4];
#pragma unroll
    for (int j = 0; j < 5; ++j) {
        int kr = i0 - 128 + 32 * j + ql; kr = kr < 0 ? 0 : kr;
        const bf16_t* kp = QK + (rowbase + (size_t)kr * dil) * 3072 + 1536 + hh * 64 + hi * 8;
#pragma unroll
        for (int s = 0; s < 4; ++s) kf[j][s] = *(const bf16x8*)(kp + 16 * s);
    }
    u32x4 vr[5][4];
#pragma unroll
    for (int j = 0; j < 5; ++j)
#pragma unroll
        for (int i = 0; i < 4; ++i) { int rk = i0 - 128 + 32 * j + 8 * i + (lane >> 3); rk = rk < 0 ? 0 : rk;
            vr[j][i] = *(const u32x4*)(Vb + (rowbase + (size_t)rk * dil) * 1536 + hh * 64 + (lane & 7) * 8); }
    f32x16 S[5];
    const float NEG = -INFINITY;
#pragma unroll
    for (int j = 0; j < 5; ++j) {
        const bool tv = (i0 - 128 + 32 * j) >= 0;
        f32x16 acc = {};
#pragma unroll
        for (int s = 0; s < 4; ++s) acc = __builtin_amdgcn_mfma_f32_32x32x16_bf16(kf[j][s], qf[s], acc, 0, 0, 0);
#pragma unroll
        for (int rr = 0; rr < 16; ++rr) {
            bool ok = tv;
            if (j == 0) ok = ok && (crow(rr, hi) >= ql);
            if (j == 4) ok = ok && (crow(rr, hi) <= ql);
            acc[rr] = ok ? acc[rr] : NEG;
        }
        S[j] = acc;
    }
    float mx = NEG;
#pragma unroll
    for (int j = 0; j < 5; ++j)
#pragma unroll
        for (int rr = 0; rr < 16; ++rr) mx = fmaxf(mx, S[j][rr]);
    mx = fmaxf(mx, __shfl_xor(mx, 32));
    float l = 0.f;
#pragma unroll
    for (int j = 0; j < 5; ++j)
#pragma unroll
        for (int rr = 0; rr < 16; ++rr) { const float pe = __builtin_amdgcn_exp2f(S[j][rr] - mx); S[j][rr] = pe; l += pe; }
    l += __shfl_xor(l, 32);
    const float inv = 1.f / l;
    if (hi == 0) lse2[((size_t)g * M + rowbase + (size_t)(i0 + ql) * dil) * 8 + h] = mx + __builtin_amdgcn_logf(l);
    f32x16 O0 = {}, O1 = {};
    const int li = lane & 15, gq = li >> 2, gp = li & 3, chh = (lane >> 4) & 1;
#pragma unroll
    for (int j = 0; j < 5; ++j) {
        LAS unsigned char* vb_ = vl + (j & 1) * 4096;
#pragma unroll
        for (int i = 0; i < 4; ++i) *(LAS u32x4*)(vb_ + (8 * i + (lane >> 3)) * 128 + (lane & 7) * 16) = vr[j][i];
        asm volatile("s_waitcnt lgkmcnt(0)" ::: "memory");
#pragma unroll
        for (int s = 0; s < 2; ++s) {
            u32x4 pw;
            pw.x = pk2(S[j][8 * s + 0] * inv, S[j][8 * s + 1] * inv); pw.y = pk2(S[j][8 * s + 2] * inv, S[j][8 * s + 3] * inv);
            pw.z = pk2(S[j][8 * s + 4] * inv, S[j][8 * s + 5] * inv); pw.w = pk2(S[j][8 * s + 6] * inv, S[j][8 * s + 7] * inv);
            const bf16x8 pa = __builtin_bit_cast(bf16x8, pw);
#pragma unroll
            for (int db = 0; db < 2; ++db) {
                const LAS unsigned char* a1 = vb_ + (16 * s + 4 * hi + gq) * 128 + (32 * db + 16 * chh + 4 * gp) * 2;
                const s16x4 lo = vtr(a1), hv = vtr(a1 + 8 * 128);
                const bf16x8 vb = {lo[0], lo[1], lo[2], lo[3], hv[0], hv[1], hv[2], hv[3]};
                if (db == 0) O0 = __builtin_amdgcn_mfma_f32_32x32x16_bf16(pa, vb, O0, 0, 0, 0);
                else O1 = __builtin_amdgcn_mfma_f32_32x32x16_bf16(pa, vb, O1, 0, 0, 0);
            }
        }
    }
    asm volatile("s_waitcnt lgkmcnt(0)" ::: "memory");
#pragma unroll
    for (int rr = 0; rr < 16; ++rr) { const int q = crow(rr, hi);
        *(LAS bf16_t*)(vl + q * 128 + ql * 2) = (bf16_t)(pk2(O0[rr], 0.f) & 0xffffu);
        *(LAS bf16_t*)(vl + q * 128 + (32 + ql) * 2) = (bf16_t)(pk2(O1[rr], 0.f) & 0xffffu); }
    asm volatile("s_waitcnt lgkmcnt(0)" ::: "memory");
#pragma unroll
    for (int i = 0; i < 4; ++i) { const int rq = 8 * i + (lane >> 3), ch = lane & 7;
        const u32x4 v = *(const LAS u32x4*)(vl + rq * 128 + ch * 16);
        *(u32x4*)(QK + (rowbase + (size_t)(i0 + rq) * dil) * 3072 + hh * 64 + ch * 8) = v; }
    asm volatile("s_waitcnt lgkmcnt(0)" ::: "memory");
}

__device__ __forceinline__ float transpose_reduce32(float (&a)[32], int lane) {
#pragma unroll
    for (int n = 16; n >= 1; n >>= 1) {
        const bool bit = (lane & n) != 0;
#pragma unroll
        for (int i = 0; i < n; ++i) { const float lo = a[i], hv = a[i + n]; const float send = bit ? lo : hv, keep = bit ? hv : lo; a[i] = keep + __shfl_xor(send, n); }
    }
    return a[0] + __shfl_xor(a[0], 32);
}

__global__ void __launch_bounds__(512, 2) mk_fwd(Args args) {
    extern __shared__ __attribute__((aligned(16))) unsigned char lds_raw[];
    LAS unsigned char* lds = (LAS unsigned char*)lds_raw;
    cg::grid_group grid = cg::this_grid();
    const int tid = threadIdx.x, lane = tid & 63, wave = __builtin_amdgcn_readfirstlane(tid >> 6);
    const int G = gridDim.x, bx = blockIdx.x;
    const int vcu = (G % 8 == 0) ? (bx % 8) * (G / 8) + bx / 8 : bx;
    const int gw = vcu * 8 + wave, NGW = G * 8;
    const int gtid = bx * 512 + tid, NT = G * 512;
    unsigned char* ws = args.ws;
#if defined(PROBE_LO)
#define TSB ((unsigned long long*)(args.ws + 65536))
#define STAMP(k) do { if (blockIdx.x == 0 && threadIdx.x == 0) TSB[k] = __builtin_amdgcn_s_memrealtime(); } while (0)
    STAMP(0);
#else
#define STAMP(k) do {} while (0)
#endif
    for (int u = tid; u < (LDS_BYTES - 131072) / 4; u += 512) ((LAS unsigned*)(lds + 131072))[u] = 0u;
    __syncthreads();
    volatile LAS unsigned* MISC = (volatile LAS unsigned*)(lds + 131072 + 320);
    unsigned* ctl = (unsigned*)(ws + WS_CTL);
    const float* x = args.in[0];
    float* out = args.out;
    float* cs = (float*)(ws + WS_CS);
    float* ss = (float*)(ws + WS_SS);
    float* vst = (float*)(ws + WS_VST);
    float* lse2 = (float*)(ws + WS_LSE);
    bf16_t* Win0 = (bf16_t*)(ws + WS_WIN0); bf16_t* Wout0 = (bf16_t*)(ws + WS_WOUT0); bf16_t* W1_0 = (bf16_t*)(ws + WS_W1_0); bf16_t* W2_0 = (bf16_t*)(ws + WS_W2_0);
    bf16_t* Win1 = (bf16_t*)(ws + WS_WIN1); bf16_t* Wout1 = (bf16_t*)(ws + WS_WOUT1); bf16_t* W1_1 = (bf16_t*)(ws + WS_W1_1); bf16_t* W2_1 = (bf16_t*)(ws + WS_W2_1);
    bf16_t* R1 = (bf16_t*)(ws + WS_R1); bf16_t* GLU = (bf16_t*)(ws + WS_GLU); bf16_t* H1B = (bf16_t*)(ws + WS_H1B);
    bf16_t* QK = (bf16_t*)(ws + WS_QK); bf16_t* VB = (bf16_t*)(ws + WS_V); bf16_t* U = (bf16_t*)(ws + WS_U);
    bf16_t* GB = (bf16_t*)(ws + WS_GB); bf16_t* GG = (bf16_t*)(ws + WS_G); bf16_t* UB = (bf16_t*)(ws + WS_UB); bf16_t* VT = (bf16_t*)(ws + WS_VT); bf16_t* MIX1 = (bf16_t*)(ws + WS_MIX1);

    {
        for (int i = gtid; i < 4096; i += NT) ctl[i] = 0u;
        for (int i = gtid; i < 4 * M + 2 * M; i += NT) { if (i < 4 * M) ss[M + i] = 0.f; else vst[i - 4 * M] = 0.f; }
        for (int i = gtid; i < SEQ * 32; i += NT) { const int s = i >> 5, f = i & 31; const float inv = powf(10000.0f, -(float)f / 32.0f); const float ang = (float)s * inv; float sn, c; sincosf(ang, &sn, &c); cs[2 * i] = c; cs[2 * i + 1] = sn; }
        { float* ckT = (float*)(ws + WS_CKT); const float* ck_ = args.in[4]; for (int i = gtid; i < 512 * 32; i += NT) { const int c_ = i >> 5, j_ = i & 31; ckT[i] = (j_ < 31) ? ck_[j_ * 512 + c_] : 0.f; } }
        LAS float* scr = (LAS float*)(lds + wave * 16384);
        constexpr int I_IN0 = 16 * (NIN0 / 32), I_OUT = 16 * 32, I_W1 = 16 * (FF / 32), I_W2 = 64 * 32, I_IN1 = 16 * (NIN1 / 32);
        constexpr int NITEMS = I_IN0 + I_OUT + I_W1 + I_W2 + I_IN1 + I_OUT + I_W1 + I_W2;
        for (int it = gw; it < NITEMS; it += NGW) {
            int q = it;
            if (q < I_IN0) { transpose_item<1>(args.in[3], 1024, NIN0, args.in[1], Win0, scr, q, lane); continue; } q -= I_IN0;
            if (q < I_OUT) { transpose_item<0>(args.in[8], 1024, 1024, nullptr, Wout0, scr, q, lane); continue; } q -= I_OUT;
            if (q < I_W1) { transpose_item<0>(args.in[16], 1024, FF, args.in[2], W1_0, scr, q, lane); continue; } q -= I_W1;
            if (q < I_W2) { transpose_item<0>(args.in[17], FF, 1024, nullptr, W2_0, scr, q, lane); continue; } q -= I_W2;
            if (q < I_IN1) { transpose_item<2>(args.in[9], 1024, NIN1, args.in[1] + 1024, Win1, scr, q, lane); continue; } q -= I_IN1;
            if (q < I_OUT) { transpose_item<0>(args.in[15], 1024, 1024, nullptr, Wout1, scr, q, lane); continue; } q -= I_OUT;
            if (q < I_W1) { transpose_item<0>(args.in[16] + (size_t)1024 * FF, 1024, FF, args.in[2] + 1024, W1_1, scr, q, lane); continue; } q -= I_W1;
            transpose_item<0>(args.in[17] + (size_t)FF * 1024, FF, 1024, nullptr, W2_1, scr, q, lane);
        }
        for (int row = gw; row < M; row += NGW) {
            const f32x4* xr = (const f32x4*)(x + (size_t)row * 1024) + lane; float s = 0.f;
            unsigned long long* o8 = (unsigned long long*)(R1 + (size_t)row * 1024) + lane;
#pragma unroll
            for (int j = 0; j < 4; ++j) { const f32x4 v = xr[64 * j]; s += (v[0] * v[0] + v[1] * v[1]) + (v[2] * v[2] + v[3] * v[3]); o8[64 * j] = (unsigned long long)pk2(v[0], v[1]) | ((unsigned long long)pk2(v[2], v[3]) << 32); }
            s = wave_sum(s); if (lane == 0) ss[row] = s;
        }
    }
    grid.sync();
    const XcdBarrier bar = xcd_barrier_post(ctl, MISC + 8);
    STAMP(1);
    {
        pg8::Gemm g{R1, Win0, M, NIN0, 1024}; pg8::StaticOrder S; S.init(M, NIN0, G, bx);
        pg8::EpiP p{}; p.ss = ss; p.o0 = GLU; p.o1 = QK; p.o2 = VB; p.cs = cs;
        pg8::Epi<0> E{p};
        pg8::gemm_phase<pg8::Epi<0>, pg8::StaticOrder, true, true>(lds, g, S, E);
    }
    xcd_barrier(bar);
    STAMP(2);
    {
#ifndef NO_ATTN
        for (int unit = vcu; unit < 256; unit += G) {
            const int b = unit >> 5, h = (unit >> 2) & 7, tb = unit & 3;
            LAS unsigned char* vl = lds + wave * 8192;
#pragma unroll 1
            for (int k = 0; k < 6; ++k) {
                const int wu = __builtin_amdgcn_readfirstlane(k * 8 + wave);
                const int g = wu >> 4, e = wu & 15;
                int r, i0;
                if (g == 0) { r = 0; i0 = tb * 512 + 32 * e; }
                else if (g == 1) { r = e & 3; i0 = tb * 128 + 32 * (e >> 2); }
                else { r = e; i0 = tb * 32; }
                attn_wave_unit(QK, VB, lse2, b, g, h, r, i0, vl, lane);
            }
            asm volatile("s_waitcnt vmcnt(0)" ::: "memory");
            __syncthreads();
            STAMP(20);
#pragma unroll 2
            for (int it = 0; it < 8; ++it) {
                const int tl = it * 64 + (tid >> 3), ch = tid & 7; const size_t row = (size_t)b * SEQ + tb * 512 + tl;
                const float l0 = lse2[((size_t)0 * M + row) * 8 + h], l1 = lse2[((size_t)1 * M + row) * 8 + h], l2 = lse2[((size_t)2 * M + row) * 8 + h];
                const float mxl = fmaxf(l0, fmaxf(l1, l2));
                float e0 = __builtin_amdgcn_exp2f(l0 - mxl), e1 = __builtin_amdgcn_exp2f(l1 - mxl), e2 = __builtin_amdgcn_exp2f(l2 - mxl);
                const float inv = 1.f / (e0 + e1 + e2); e0 *= inv; e1 *= inv; e2 *= inv;
                const u32x4 a0 = *(const u32x4*)(QK + row * 3072 + (0 + h) * 64 + ch * 8), a1 = *(const u32x4*)(QK + row * 3072 + (8 + h) * 64 + ch * 8), a2 = *(const u32x4*)(QK + row * 3072 + (16 + h) * 64 + ch * 8);
                u32x4 o;
#pragma unroll
                for (int w = 0; w < 4; ++w) o[w] = pk2(e0 * bflo(a0[w]) + e1 * bflo(a1[w]) + e2 * bflo(a2[w]), e0 * bfhi(a0[w]) + e1 * bfhi(a1[w]) + e2 * bfhi(a2[w]));
                *(u32x4*)(R1 + row * 1024 + 512 + h * 64 + ch * 8) = o;
            }
            __syncthreads();
        }
    STAMP(21);
#endif
#ifndef NO_CONV
        const float* cb = args.in[5]; const float* lg = args.in[6]; const float* lb = args.in[7];
        LAS float* part = (LAS float*)(lds + 65536); LAS float* stat = (LAS float*)(lds + 65536 + 4096);
        for (int tile = vcu; tile < 512; tile += G) {
            int tidc = threadIdx.x; asm volatile("" : "+v"(tidc));
            const int t0 = tile * 32, tseq = t0 & 2047;
            {
                const int ch = tidc & 63, r0 = tidc >> 6;
                const bf16_t* gp = GLU + (size_t)(t0 - 30 + r0) * 512 + ch * 8;
                LAS unsigned char* lp = lds + r0 * 1024 + ch * 16;
#pragma unroll
                for (int it = 0; it < 8; ++it) { const int rr = r0 + 8 * it;
                    if (rr < 62) { u32x4 v = {0u, 0u, 0u, 0u}; if (tseq - 30 + rr >= 0) v = *(const u32x4*)(gp + (size_t)it * 8 * 512); *(LAS u32x4*)(lp + it * 8192) = v; } }
            }
            __syncthreads();
            const int c = tidc;
            float o[32];
            {
                float kk[32];
                { const f32x4* kp4 = (const f32x4*)((const float*)(ws + WS_CKT) + c * 32);
#pragma unroll
                  for (int j4 = 0; j4 < 8; ++j4) { const f32x4 kq = kp4[j4]; kk[4 * j4] = kq[0]; kk[4 * j4 + 1] = kq[1]; kk[4 * j4 + 2] = kq[2]; kk[4 * j4 + 3] = kq[3]; } }
                const float bias = cb[c];
                float xv[62];
#pragma unroll
                for (int i = 0; i < 46; ++i) xv[i] = bf2f(*(const LAS bf16_t*)(lds + i * 1024 + c * 2));
#pragma unroll
                for (int t = 0; t < 16; ++t) { float acc = bias;
#pragma unroll
                    for (int j = 0; j < 31; ++j) acc += kk[j] * xv[t + j];
                    o[t] = acc; }
                asm volatile("" ::: "memory");
#pragma unroll
                for (int i = 46; i < 62; ++i) xv[i] = bf2f(*(const LAS bf16_t*)(lds + i * 1024 + c * 2));
#pragma unroll
                for (int t = 16; t < 32; ++t) { float acc = bias;
#pragma unroll
                    for (int j = 0; j < 31; ++j) acc += kk[j] * xv[t + j];
                    o[t] = acc; }
            }
            {
                float a[32];
#pragma unroll
                for (int t = 0; t < 32; ++t) a[t] = o[t];
                const float s1 = transpose_reduce32(a, lane);
#pragma unroll
                for (int t = 0; t < 32; ++t) a[t] = o[t] * o[t];
                const float s2 = transpose_reduce32(a, lane);
                if (lane < 32) { part[(lane * 8 + wave) * 2] = s1; part[(lane * 8 + wave) * 2 + 1] = s2; }
            }
            __syncthreads();
            if (tidc < 32) { float s1 = 0.f, s2 = 0.f;
#pragma unroll
                for (int w = 0; w < 8; ++w) { s1 += part[(tidc * 8 + w) * 2]; s2 += part[(tidc * 8 + w) * 2 + 1]; }
                const float mean = s1 * (1.f / 512.f), var = s2 * (1.f / 512.f) - mean * mean;
                stat[2 * tidc] = mean; stat[2 * tidc + 1] = rsqrtf(fmaxf(var, 0.f) + EPS); }
            __syncthreads();
            const float lgc = lg[c], lbc = lb[c];
#pragma unroll
            for (int t = 0; t < 32; ++t) { const float mean = stat[2 * t], rstd = stat[2 * t + 1]; const float y = (o[t] - mean) * rstd * lgc + lbc; const float a = y * pg8::sigm(y);
                *(LAS bf16_t*)(lds + t * 1024 + c * 2) = (bf16_t)(pk2(a, 0.f) & 0xffffu); }
            __syncthreads();
            for (int idx = tidc; idx < 32 * 64; idx += 512) { const int rr = idx >> 6, ch = idx & 63; const u32x4 v = *(const LAS u32x4*)(lds + rr * 1024 + ch * 16); *(u32x4*)(R1 + (size_t)(t0 + rr) * 1024 + ch * 8) = v; }
            __syncthreads();
        }
#endif
    }
    xcd_barrier(bar);
    STAMP(3);
    {
        pg8::Gemm g{R1, Wout0, M, 1024, 1024}; pg8::StaticOrder S; S.init(M, 1024, G, bx);
        pg8::EpiP p{}; p.resid = x; p.hout = out; p.hb = H1B; p.ss_out = ss + M;
        pg8::Epi<1> E{p};
        pg8::gemm_phase<pg8::Epi<1>, pg8::StaticOrder, true, true>(lds, g, S, E);
    }
    xcd_barrier(bar);
    STAMP(4);
    {
        pg8::Gemm g{H1B, W1_0, M, FF, 1024}; pg8::StaticOrder S; S.init(M, FF, G, bx);
        pg8::EpiP p{}; p.ss = ss + M; p.o0 = U;
        pg8::Epi<2> E{p};
        pg8::gemm_phase<pg8::Epi<2>, pg8::StaticOrder, true, true>(lds, g, S, E);
    }
    xcd_barrier(bar);
    STAMP(5);
    {
        pg8::Gemm g{U, W2_0, M, 1024, FF}; pg8::StaticOrder S; S.init(M, 1024, G, bx);
        pg8::EpiP p{}; p.resid = out; p.hout = out; p.hb = R1; p.ss_out = ss + 2 * M;
        pg8::Epi<1> E{p};
        pg8::gemm_phase<pg8::Epi<1>, pg8::StaticOrder, true, true>(lds, g, S, E);
    }
    xcd_barrier(bar);
    STAMP(6);
    {
        pg8::Gemm g{R1, Win1, M, NIN1, 1024}; pg8::StaticOrder S; S.init(M, NIN1, G, bx);
        pg8::EpiP p{}; p.ss = ss + 2 * M; p.o0 = GB; p.o1 = GG; p.o2 = UB; p.o3 = VT; p.vst = vst;
        pg8::Epi<3> E{p};
        pg8::gemm_phase<pg8::Epi<3>, pg8::StaticOrder, true, true>(lds, g, S, E);
    }
    xcd_barrier(bar);
    STAMP(7);
    {
        const float* sk = args.in[10]; const float* lg = args.in[11]; const float* lb = args.in[12]; const float* sgw = args.in[13]; const float* sgb = args.in[14];
        for (int idx = gtid; idx < M * 64; idx += NT) {
            const int row = idx >> 6, ch = idx & 63, tseq = row & 2047;
            const u32x4 gbv = *(const u32x4*)(GB + (size_t)row * 512 + ch * 8);
            float acc[8];
#pragma unroll
            for (int e = 0; e < 8; ++e) acc[e] = 0.f;
#pragma unroll
            for (int j = 0; j < 3; ++j) {
                if (tseq - 2 + j >= 0) {
                    const u32x4 gv = *(const u32x4*)(GG + (size_t)(row - 2 + j) * 512 + ch * 8);
                    const f32x4 k0 = *(const f32x4*)(sk + j * 512 + ch * 8), k1 = *(const f32x4*)(sk + j * 512 + ch * 8 + 4);
                    acc[0] += k0[0] * bflo(gv[0]); acc[1] += k0[1] * bfhi(gv[0]); acc[2] += k0[2] * bflo(gv[1]); acc[3] += k0[3] * bfhi(gv[1]);
                    acc[4] += k1[0] * bflo(gv[2]); acc[5] += k1[1] * bfhi(gv[2]); acc[6] += k1[2] * bflo(gv[3]); acc[7] += k1[3] * bfhi(gv[3]);
                }
            }
            u32x4 o;
#pragma unroll
            for (int w = 0; w < 4; ++w) o[w] = pk2(bflo(gbv[w]) * acc[2 * w], bfhi(gbv[w]) * acc[2 * w + 1]);
            *(u32x4*)(MIX1 + (size_t)row * 1024 + ch * 8) = o;
        }
#ifndef NO_SGU
        LAS float* RS = (LAS float*)lds; LAS float* MU = RS + 128; LAS float* RHO = RS + 256; LAS float* SIG = RS + 384;
        const int ql = lane & 31, hi = lane >> 5;
        for (int unit = vcu; unit < 512; unit += G) {
            const int n = unit >> 2, gi = unit & 3, tok0 = n * 128;
            if (tid < 128) { const float sm = vst[2 * (tok0 + tid)], sq = vst[2 * (tok0 + tid) + 1]; const float mean = sm * (1.f / 512.f), var = sq * (1.f / 512.f) - mean * mean;
                RS[tid] = rsqrtf(fmaxf(var, 0.f) + EPS); MU[tid] = mean; }
            __syncthreads();
            if (tid < 128) { const float* wr_ = sgw + ((size_t)gi * 128 + tid) * 128; float sg = 0.f, rho = 0.f;
                for (int s = 0; s <= tid; ++s) { const float w = wr_[s]; sg += w; rho += w * RS[s] * MU[s]; }
                RHO[tid] = rho; SIG[tid] = sg; }
            const int tr = wave >> 1, tc0 = (wave & 1) * 2;
            f32x16 D0 = {}, D1 = {};
            const int t = 32 * tr + ql;
            const float* wp = sgw + ((size_t)gi * 128 + t) * 128 + 8 * hi;
            const bf16_t* vp0 = VT + ((size_t)gi * 128 + 32 * tc0 + ql) * M + tok0 + 8 * hi;
            const bf16_t* vp1 = vp0 + (size_t)32 * M;
            for (int s0 = 0; s0 < 32 * (tr + 1); s0 += 16) {
                const f32x4 w0 = *(const f32x4*)(wp + s0), w1 = *(const f32x4*)(wp + s0 + 4);
                float av[8];
#pragma unroll
                for (int j = 0; j < 4; ++j) { av[j] = w0[j]; av[j + 4] = w1[j]; }
#pragma unroll
                for (int j = 0; j < 8; ++j) { const int s = s0 + 8 * hi + j; av[j] = (s <= t) ? av[j] * RS[s] : 0.f; }
                u32x4 aw; aw.x = pk2(av[0], av[1]); aw.y = pk2(av[2], av[3]); aw.z = pk2(av[4], av[5]); aw.w = pk2(av[6], av[7]);
                const bf16x8 af = __builtin_bit_cast(bf16x8, aw);
                const bf16x8 b0 = *(const bf16x8*)(vp0 + s0), b1 = *(const bf16x8*)(vp1 + s0);
                D0 = __builtin_amdgcn_mfma_f32_32x32x16_bf16(af, b0, D0, 0, 0, 0);
                D1 = __builtin_amdgcn_mfma_f32_32x32x16_bf16(af, b1, D1, 0, 0, 0);
            }
            __syncthreads();
#pragma unroll
            for (int q = 0; q < 2; ++q) {
                const int chn = gi * 128 + 32 * (tc0 + q) + ql; const float lgc = lg[chn], lbc = lb[chn];
#pragma unroll
                for (int rr = 0; rr < 16; ++rr) { const int tt = 32 * tr + crow(rr, hi); const size_t token = (size_t)tok0 + tt;
                    const float dv = (q == 0) ? D0[rr] : D1[rr];
                    const float val = lgc * (dv - RHO[tt]) + lbc * SIG[tt] + sgb[gi * 128 + tt];
                    const float uu = bf2f(UB[token * 512 + chn]);
                    MIX1[token * 1024 + 512 + chn] = (bf16_t)(pk2(uu * val, 0.f) & 0xffffu); }
            }
            __syncthreads();
        }
#endif
    }
    xcd_barrier(bar);
    STAMP(8);
    {
        pg8::Gemm g{MIX1, Wout1, M, 1024, 1024}; pg8::StaticOrder S; S.init(M, 1024, G, bx);
        pg8::EpiP p{}; p.resid = out; p.hout = out; p.hb = R1; p.ss_out = ss + 3 * M;
        pg8::Epi<1> E{p};
        pg8::gemm_phase<pg8::Epi<1>, pg8::StaticOrder, true, true>(lds, g, S, E);
    }
    xcd_barrier(bar);
    STAMP(9);
    {
        pg8::Gemm g{R1, W1_1, M, FF, 1024}; pg8::StaticOrder S; S.init(M, FF, G, bx);
        pg8::EpiP p{}; p.ss = ss + 3 * M; p.o0 = U;
        pg8::Epi<2> E{p};
        pg8::gemm_phase<pg8::Epi<2>, pg8::StaticOrder, true, true>(lds, g, S, E);
    }
    xcd_barrier(bar);
    STAMP(10);
    {
        pg8::Gemm g{U, W2_1, M, 1024, FF}; pg8::StaticOrder S; S.init(M, 1024, G, bx);
        pg8::EpiP p{}; p.resid = out; p.hout = out; p.hb = nullptr; p.ss_out = ss + 4 * M;
        pg8::Epi<1> E{p};
        pg8::gemm_phase<pg8::Epi<1>, pg8::StaticOrder, true, true>(lds, g, S, E);
    }
    xcd_barrier(bar);
    STAMP(11);
    {
        const float* fg = args.in[18];
        for (int row = gw; row < M; row += NGW) {
            const float r = rsqrtf(ss[4 * M + row] * (1.f / 1024.f) + EPS);
            f32x4* orow = (f32x4*)(out + (size_t)row * 1024) + lane; const f32x4* gr = (const f32x4*)fg + lane;
#pragma unroll
            for (int j = 0; j < 4; ++j) { const f32x4 v = orow[64 * j]; orow[64 * j] = v * r * gr[64 * j]; }
        }
    }
#if defined(PROBE_LO)
    xcd_barrier(bar);
    STAMP(12);
    xcd_barrier(bar);
    {
        const float XA = (float)(TSB[PROBE_HI] - TSB[PROBE_LO]) * 0.01f, YB = 0.f;
        float* o_ = args.out; const int g_ = blockIdx.x * 512 + threadIdx.x, n_ = gridDim.x * 512;
        (void)n_; (void)YB;
        if (g_ == 0) o_[0] = XA;
    }
#endif
}

extern "C" void kernel_launch(void* const* d_in, const int* in_sizes, int n_in, void* d_out, int out_size, void* d_ws, size_t ws_size, hipStream_t stream) {
    static int grid = 0;
    if (grid == 0) {
        if (n_in != 19 || out_size != M * DM || ws_size < WS_END) { fprintf(stderr, "kernel_launch: unexpected shapes (n_in %d out %d ws %zu)\n", n_in, out_size, ws_size); grid = -1; return; }
        int dev = 0, cus = 0, per_cu = 0;
        hipGetDevice(&dev); hipDeviceGetAttribute(&cus, hipDeviceAttributeMultiprocessorCount, dev);
        if (hipFuncSetAttribute((const void*)mk_fwd, hipFuncAttributeMaxDynamicSharedMemorySize, LDS_BYTES) != hipSuccess) { fprintf(stderr, "kernel_launch: hipFuncSetAttribute failed\n"); grid = -1; return; }
        if (hipOccupancyMaxActiveBlocksPerMultiprocessor(&per_cu, (const void*)mk_fwd, 512, LDS_BYTES) != hipSuccess || per_cu < 1) { fprintf(stderr, "kernel_launch: occupancy query says %d\n", per_cu); per_cu = 1; }
        (void)hipGetLastError();
        grid = cus;
        fprintf(stderr, "kernel_launch: cus %d per_cu %d grid %d\n", cus, per_cu, grid);
    }
    if (grid < 0) return;
    Args a{};
    for (int i = 0; i < 19; ++i) a.in[i] = (const float*)d_in[i];
    a.out = (float*)d_out; a.ws = (unsigned char*)d_ws;
    void* kargs[] = {&a};
    hipError_t e = hipLaunchCooperativeKernel((const void*)mk_fwd, dim3(grid), dim3(512), kargs, LDS_BYTES, stream);
    if (e != hipSuccess) fprintf(stderr, "cooperative launch failed: %s (grid %d)\n", hipGetErrorString(e), grid);
}
```

```cpp
#include <hip/hip_runtime.h>
#include <hip/hip_cooperative_groups.h>
#include <cstdio>
#include <cstdint>
namespace cg = cooperative_groups;

#ifndef MK_CHECK
#define MK_CHECK 0
#endif

constexpr int M = 16384, DM = 1024, SEQ = 2048, NIN0 = 5632, NIN1 = 2560, FF = 4096;
constexpr float EPS = 1e-6f;
constexpr float QSCALE = 0.125f * 1.4426950408889634f;
constexpr size_t MiB = 1u << 20;
constexpr size_t WS_CTL = 0;
constexpr size_t WS_CS = 1 * MiB;
constexpr size_t WS_SS = WS_CS + 512 * 1024;
constexpr size_t WS_VST = WS_SS + 5 * M * 4;
constexpr size_t WS_CKT = WS_VST + 2 * M * 4;
constexpr size_t WS_LSE = 2 * MiB;
constexpr size_t WS_W = 4 * MiB;
constexpr size_t WS_WIN0 = WS_W, WS_WOUT0 = WS_WIN0 + 11 * MiB, WS_W1_0 = WS_WOUT0 + 2 * MiB, WS_W2_0 = WS_W1_0 + 8 * MiB;
constexpr size_t WS_WIN1 = WS_W2_0 + 8 * MiB, WS_WOUT1 = WS_WIN1 + 5 * MiB, WS_W1_1 = WS_WOUT1 + 2 * MiB, WS_W2_1 = WS_W1_1 + 8 * MiB;
constexpr size_t WS_R1 = 56 * MiB;
constexpr size_t WS_GLU = 88 * MiB;
constexpr size_t WS_H1B = 88 * MiB;
constexpr size_t WS_QK = 104 * MiB;
constexpr size_t WS_V = 200 * MiB;
constexpr size_t WS_U = 120 * MiB;
constexpr size_t WS_GB = 88 * MiB, WS_G = 104 * MiB, WS_UB = 120 * MiB, WS_VT = 136 * MiB, WS_MIX1 = 152 * MiB;
constexpr size_t WS_END = 248 * MiB;
static_assert(WS_W2_1 + 8 * MiB == WS_R1, "weights end at R1");
constexpr int LDS_BYTES = 147456;

namespace pg8 {
#define PG8_LAS __attribute__((address_space(3)))
typedef unsigned short bf16_t;
typedef short bf16x8 __attribute__((ext_vector_type(8)));
typedef float f32x4 __attribute__((ext_vector_type(4)));
typedef unsigned u32x4 __attribute__((ext_vector_type(4)));
constexpr int BM = 256, BK = 64, HALF = 128, HTB = HALF * BK * 2  , STAGE_BYTES = 8 * HTB, NXCD = 8, WGM = 8;

__host__ __device__ __forceinline__ int lds_byte(int r, int c) { const int st = (r >> 4) * 2 + (c >> 5), rr = r & 15, cc = c & 31, ob = rr * 64 + cc * 2; return st * 1024 + (ob ^ (((ob >> 9) & 1) << 5)); }
__host__ __device__ __forceinline__ void stage_rc(int b, int& R, int& C) { const int st = b / 1024, sb = b % 1024, swz = sb ^ (((sb >> 9) & 1) << 5); R = (st >> 1) * 16 + swz / 64; C = (st & 1) * 32 + (swz % 64) / 2; }
__host__ __device__ __forceinline__ int perm32(int rho) { const int n = rho >> 4, i = rho & 15; return 8 * (i >> 2) + 4 * n + (i & 3); }

struct Unit { int pm, pn; };
struct Gemm { const bf16_t* A; const bf16_t* Bt; int M, N, K; };

struct StaticOrder {
    int nM, nN, nwg, G, c;
    __host__ __device__ void init(int M, int N, int G_, int c_) { nM = M / BM; nN = N / BM; nwg = nM * nN; G = G_; c = c_; }
    __host__ __device__ bool next(int i, Unit& u) const {
        const long L = (long)i * G + c; if (L >= nwg) return false;
        int wgid = (int)L; { const int q = nwg / NXCD, r = nwg % NXCD, xcd = wgid % NXCD, off = wgid / NXCD; wgid = (xcd < r ? xcd * (q + 1) : r * (q + 1) + (xcd - r) * q) + off; }
        const int nig = WGM * nN, gid = wgid / nig, fm = gid * WGM, gsz = (nM - fm) < WGM ? (nM - fm) : WGM;
        u.pm = fm + ((wgid % nig) % gsz); u.pn = (wgid % nig) / gsz; return true;
    }
    __device__ __forceinline__ void a_ready(const Unit&) const {}
    __device__ __forceinline__ void done(const Unit&) const {}
};

__device__ __forceinline__ unsigned cvt_pk_bf16(float lo, float hi) { unsigned r; asm volatile("v_cvt_pk_bf16_f32 %0, %1, %2" : "=v"(r) : "v"(lo), "v"(hi)); return r; }
typedef float f32x2 __attribute__((ext_vector_type(2)));
typedef unsigned u32x2 __attribute__((ext_vector_type(2)));
__device__ __forceinline__ void store8(bf16_t* p, const f32x4& a, const f32x4& b) { u32x4 w; w.x = cvt_pk_bf16(a[0], a[1]); w.y = cvt_pk_bf16(a[2], a[3]); w.z = cvt_pk_bf16(b[0], b[1]); w.w = cvt_pk_bf16(b[2], b[3]); *(u32x4*)p = w; }
__device__ __forceinline__ void store4(bf16_t* p, const f32x4& a) { u32x2 w; w.x = cvt_pk_bf16(a[0], a[1]); w.y = cvt_pk_bf16(a[2], a[3]); *(u32x2*)p = w; }
__device__ __forceinline__ float sigm(float x) { return __builtin_amdgcn_rcpf(1.f + __expf(-x)); }
__device__ __forceinline__ float gelu_t(float x) { const float t = 1.5957691216057308f * (x + 0.044715f * x * x * x); return x * sigm(t); }
struct EpiP {
    const float* ss; float* ss_out; const float* resid; float* hout; bf16_t* hb;
    bf16_t* o0; bf16_t* o1; bf16_t* o2; bf16_t* o3; const float* cs; float* vst;
};
template <int KIND> struct Epi {
    static constexpr bool PERM = true, AFTER_DRAIN = false;
    EpiP p;
    __device__ __forceinline__ void operator()(const f32x4 (&acc)[2][2][4][2], const Unit& u, int wr, int wc, int fr, int fq) const {
        const int colt = u.pn * BM + wc * 32 + 8 * fq;
#pragma unroll
        for (int ai = 0; ai < 2; ++ai)
#pragma unroll
            for (int m = 0; m < 4; ++m) {
                const int row = u.pm * BM + ai * HALF + wr * 64 + m * 16 + fr;
                float r = 1.f;
                if (KIND != 1) r = rsqrtf(p.ss[row] * (1.f / 1024.f) + 1e-6f);
                float sq = 0.f, s1 = 0.f;
#pragma unroll
                for (int bj = 0; bj < 2; ++bj) {
                    const int c0 = colt + bj * HALF;
                    f32x4 v0 = acc[ai][bj][m][0] * r, v1 = acc[ai][bj][m][1] * r;
                    if (KIND == 0) {
                        if (u.pn < 4) {
                            f32x4 o;
#pragma unroll
                            for (int j = 0; j < 4; ++j) o[j] = v0[j] * sigm(v1[j]);
                            store4(p.o0 + (size_t)row * 512 + (c0 >> 1), o);
                        } else if (u.pn < 16) {
                            const int qq = ((c0 - 1024) & 63) >> 3, pos = row & 2047;
                            const f32x4* t = (const f32x4*)(p.cs + ((size_t)pos * 32 + 4 * qq) * 2);
                            const f32x4 t0 = t[0], t1 = t[1];
                            const f32x4 cc = {t0[0], t0[2], t1[0], t1[2]}, sn = {t0[1], t0[3], t1[1], t1[3]};
                            f32x4 o1 = v0 * cc - v1 * sn, o2 = v1 * cc + v0 * sn;
                            if (u.pn < 10) { o1 = o1 * QSCALE; o2 = o2 * QSCALE; }
                            store8(p.o1 + (size_t)row * 3072 + (c0 - 1024), o1, o2);
                        } else {
                            store8(p.o2 + (size_t)row * 1536 + (c0 - 4096), v0, v1);
                        }
                    } else if (KIND == 1) {
                        const size_t off = (size_t)row * 1024 + c0;
                        const f32x4 r0 = *(const f32x4*)(p.resid + off), r1 = *(const f32x4*)(p.resid + off + 4);
                        v0 = v0 + r0; v1 = v1 + r1;
                        *(f32x4*)(p.hout + off) = v0; *(f32x4*)(p.hout + off + 4) = v1;
                        if (p.hb) store8(p.hb + off, v0, v1);
#pragma unroll
                        for (int j = 0; j < 4; ++j) sq += v0[j] * v0[j] + v1[j] * v1[j];
                    } else if (KIND == 2) {
#pragma unroll
                        for (int j = 0; j < 4; ++j) { float a = fmaxf(v0[j], 0.f), b = fmaxf(v1[j], 0.f); v0[j] = a * a; v1[j] = b * b; }
                        store8(p.o0 + (size_t)row * 4096 + c0, v0, v1);
                    } else {
                        if (u.pn < 2) store8(p.o0 + (size_t)row * 512 + c0, v0, v1);
                        else if (u.pn < 6) { const f32x4 o = v0 * v1; store4(p.o1 + (size_t)row * 512 + ((c0 - 512) >> 1), o); }
                        else if (u.pn < 8) {
#pragma unroll
                            for (int j = 0; j < 4; ++j) { v0[j] = gelu_t(v0[j]); v1[j] = gelu_t(v1[j]); }
                            store8(p.o2 + (size_t)row * 512 + (c0 - 1536), v0, v1);
                        } else {
                            bf16_t* vt = p.o3 + (size_t)(c0 - 2048) * ::M + row;
#pragma unroll
                            for (int j = 0; j < 4; ++j) { v0[j] = gelu_t(v0[j]); v1[j] = gelu_t(v1[j]); s1 += v0[j] + v1[j]; sq += v0[j] * v0[j] + v1[j] * v1[j]; }
#pragma unroll
                            for (int j = 0; j < 4; ++j) { vt[(size_t)j * ::M] = (bf16_t)(cvt_pk_bf16(v0[j], 0.f) & 0xffffu); vt[(size_t)(j + 4) * ::M] = (bf16_t)(cvt_pk_bf16(v1[j], 0.f) & 0xffffu); }
                        }
                    }
                }
                if (KIND == 1) {
                    sq += __shfl_xor(sq, 16); sq += __shfl_xor(sq, 32);
                    if (fq == 0) atomicAdd(p.ss_out + row, sq);
                }
                if (KIND == 3) {
                    if (u.pn >= 8) {
                        sq += __shfl_xor(sq, 16); sq += __shfl_xor(sq, 32); s1 += __shfl_xor(s1, 16); s1 += __shfl_xor(s1, 32);
                        if (fq == 0) { atomicAdd(p.vst + 2 * row, s1); atomicAdd(p.vst + 2 * row + 1, sq); }
                    }
                }
            }
    }
};
template <class Epi, class Sched, bool ALIGN_EPI = false, bool SP2 = false>
__device__ __forceinline__ void gemm_phase(PG8_LAS unsigned char* lds, const Gemm g, const Sched& S, const Epi& E) {
    int tid_ = threadIdx.x; asm volatile("" : "+v"(tid_));
    const int tid = tid_, wid = __builtin_amdgcn_readfirstlane(tid >> 6), lane = tid & 63, wr = wid >> 2, wc = wid & 3, fr = lane & 15, fq = lane >> 4;
    const int K = g.K, nt = K / BK;
    unsigned voffA[2], voffB[2];
#pragma unroll
    for (int i = 0; i < 2; ++i) { int R, C; stage_rc(tid * 16 + i * 8192, R, C); const int Rb = Epi::PERM ? ((R & ~31) + perm32(R & 31)) : R;
        voffA[i] = (unsigned)(R * K + C) * 2u; voffB[i] = (unsigned)(Rb * K + C) * 2u; }
    const size_t kstep = (size_t)(BK * 2);
    const size_t hstep = (size_t)HALF * K * 2;
    const size_t tstep = 2 * hstep;
    const unsigned ldsw = (unsigned)wid * 1024u;
    const int aoff = lds_byte(wr * 64 + fr, fq * 8), boff = lds_byte(wc * 32 + fr, fq * 8);
#define PG8_SA(b, h) (((b) * 2 + (h)) * HTB)
#define PG8_SB(b, h) ((4 + (b) * 2 + (h)) * HTB)
#define PG8_STAGE(bufoff, gbase, voff) do { _Pragma("unroll") for (int _i = 0; _i < 2; ++_i) \
        __builtin_amdgcn_global_load_lds((const unsigned*)((const char*)(gbase) + (voff)[_i]), (PG8_LAS unsigned*)(lds + (bufoff) + ldsw + _i * 8192), 16, 0, 0); } while (0)
#define PG8_LDA(dst, b, h) do { _Pragma("unroll") for (int m = 0; m < 4; ++m) _Pragma("unroll") for (int k = 0; k < 2; ++k) dst[m][k] = *(const PG8_LAS bf16x8*)(lds + PG8_SA(b, h) + aoff + m * 2048 + k * 1024); } while (0)
#define PG8_LDB(dst, b, h) do { _Pragma("unroll") for (int n = 0; n < 2; ++n) _Pragma("unroll") for (int k = 0; k < 2; ++k) dst[n][k] = *(const PG8_LAS bf16x8*)(lds + PG8_SB(b, h) + boff + n * 2048 + k * 1024); } while (0)
#define PG8_MMA(ai, bj, At, Bt) do { __builtin_amdgcn_s_setprio(1); _Pragma("unroll") for (int m = 0; m < 4; ++m) _Pragma("unroll") for (int n = 0; n < 2; ++n) _Pragma("unroll") for (int k = 0; k < 2; ++k) \
        acc[ai][bj][m][n] = __builtin_amdgcn_mfma_f32_16x16x32_bf16(Bt[n][k], At[m][k], acc[ai][bj][m][n], 0, 0, 0); __builtin_amdgcn_s_setprio(0); } while (0)
#define PG8_WAIT_V(n) asm volatile("s_waitcnt vmcnt(" #n ")" ::: "memory")
#define PG8_WAIT_L(n) asm volatile("s_waitcnt lgkmcnt(" #n ")" ::: "memory")
#define PG8_BAR __builtin_amdgcn_s_barrier()
#define PG8_SCHED __builtin_amdgcn_sched_barrier(0)
    Unit cur, nxt; int ui = 0;
    if (!S.next(0, cur)) return;
    f32x4 acc[2][2][4][2];
#pragma unroll
    for (int a = 0; a < 2; ++a)
#pragma unroll
        for (int b = 0; b < 2; ++b)
#pragma unroll
            for (int m = 0; m < 4; ++m)
#pragma unroll
                for (int n = 0; n < 2; ++n) acc[a][b][m][n] = (f32x4){0.f, 0.f, 0.f, 0.f};
    bf16x8 At[4][2], B0[2][2], B1[2][2];
    const char* cA = (const char*)g.A + (size_t)cur.pm * tstep; const char* cB = (const char*)g.Bt + (size_t)cur.pn * tstep;
    S.a_ready(cur);
    if constexpr (SP2) {
        PG8_STAGE(PG8_SB(0, 0), cB, voffB); PG8_STAGE(PG8_SB(0, 1), cB + hstep, voffB); PG8_STAGE(PG8_SA(0, 0), cA, voffA); PG8_STAGE(PG8_SA(0, 1), cA + hstep, voffA);
        if (wr == 1) PG8_BAR;
        PG8_WAIT_V(2); PG8_BAR;
        PG8_STAGE(PG8_SB(1, 0), cB + kstep, voffB); PG8_STAGE(PG8_SA(1, 0), cA + kstep, voffA); PG8_STAGE(PG8_SB(1, 1), cB + hstep + kstep, voffB);
        PG8_WAIT_V(6); PG8_BAR;
    } else {
        PG8_STAGE(PG8_SB(0, 0), cB, voffB); PG8_STAGE(PG8_SA(0, 0), cA, voffA); PG8_STAGE(PG8_SB(0, 1), cB + hstep, voffB); PG8_STAGE(PG8_SA(0, 1), cA + hstep, voffA);
        if (wr == 1) PG8_BAR;
        PG8_WAIT_V(4); PG8_BAR;
        PG8_STAGE(PG8_SB(1, 0), cB + kstep, voffB); PG8_STAGE(PG8_SA(1, 0), cA + kstep, voffA); PG8_STAGE(PG8_SB(1, 1), cB + hstep + kstep, voffB);
        PG8_WAIT_V(6); PG8_BAR;
    }
    for (;;) {
        const bool has_next = S.next(ui + 1, nxt);
        const char* nA = has_next ? (const char*)g.A + (size_t)nxt.pm * tstep : cA; const char* nB = has_next ? (const char*)g.Bt + (size_t)nxt.pn * tstep : cB;
        for (int t = 0; t < nt; t += 2) {
            const bool last = (t == nt - 2);
            const char* a1 = cA + (size_t)(t + 1) * kstep;
            const char* a2 = last ? nA : cA + (size_t)(t + 2) * kstep; const char* b2 = last ? nB : cB + (size_t)(t + 2) * kstep;
            const char* a3 = a2 + kstep; const char* b3 = b2 + kstep;
            if (last && has_next) S.a_ready(nxt);
            if constexpr (SP2) {
            PG8_LDB(B0, 0, 0); PG8_LDB(B1, 0, 1); PG8_SCHED; PG8_LDA(At, 0, 0); PG8_STAGE(PG8_SA(1, 1), a1 + hstep, voffA);
            PG8_WAIT_V(8); PG8_WAIT_L(0); PG8_BAR; PG8_MMA(0, 0, At, B0); PG8_MMA(0, 1, At, B1); PG8_BAR; PG8_SCHED;
            PG8_LDA(At, 0, 1); PG8_STAGE(PG8_SB(0, 0), b2, voffB); PG8_STAGE(PG8_SB(0, 1), b2 + hstep, voffB); PG8_STAGE(PG8_SA(0, 0), a2, voffA);
            PG8_WAIT_V(8); PG8_WAIT_L(0); PG8_BAR; PG8_MMA(1, 0, At, B0); PG8_MMA(1, 1, At, B1); PG8_BAR; PG8_SCHED;
            PG8_LDB(B0, 1, 0); PG8_LDB(B1, 1, 1); PG8_SCHED; PG8_LDA(At, 1, 0); PG8_STAGE(PG8_SA(0, 1), a2 + hstep, voffA);
            PG8_WAIT_V(8); PG8_WAIT_L(0); PG8_BAR; PG8_MMA(0, 0, At, B0); PG8_MMA(0, 1, At, B1); PG8_BAR; PG8_SCHED;
            PG8_LDA(At, 1, 1); PG8_STAGE(PG8_SB(1, 0), b3, voffB); PG8_STAGE(PG8_SB(1, 1), b3 + hstep, voffB); PG8_STAGE(PG8_SA(1, 0), a3, voffA);
            PG8_WAIT_V(8); PG8_WAIT_L(0); PG8_BAR; PG8_MMA(1, 0, At, B0); PG8_MMA(1, 1, At, B1); PG8_BAR; PG8_SCHED;
            } else {
            PG8_LDB(B0, 0, 0); PG8_SCHED; PG8_LDA(At, 0, 0); PG8_STAGE(PG8_SA(1, 1), a1 + hstep, voffA);
            PG8_WAIT_L(8); PG8_BAR; PG8_WAIT_L(0); PG8_MMA(0, 0, At, B0); PG8_BAR; PG8_SCHED;
            PG8_LDB(B1, 0, 1); PG8_STAGE(PG8_SB(0, 0), b2, voffB);
            PG8_BAR; PG8_WAIT_L(0); PG8_MMA(0, 1, At, B1); PG8_BAR;
            PG8_LDA(At, 0, 1); PG8_STAGE(PG8_SA(0, 0), a2, voffA);
            PG8_BAR; PG8_WAIT_L(0); PG8_MMA(1, 0, At, B0); PG8_BAR; PG8_SCHED;
            PG8_STAGE(PG8_SB(0, 1), b2 + hstep, voffB);
            PG8_WAIT_V(6); PG8_BAR; PG8_MMA(1, 1, At, B1); PG8_BAR;
            PG8_LDB(B0, 1, 0); PG8_SCHED; PG8_LDA(At, 1, 0); PG8_STAGE(PG8_SA(0, 1), a2 + hstep, voffA);
            PG8_WAIT_L(8); PG8_BAR; PG8_WAIT_L(0); PG8_MMA(0, 0, At, B0); PG8_BAR; PG8_SCHED;
            PG8_LDB(B1, 1, 1); PG8_STAGE(PG8_SB(1, 0), b3, voffB);
            PG8_BAR; PG8_WAIT_L(0); PG8_MMA(0, 1, At, B1); PG8_BAR;
            PG8_LDA(At, 1, 1); PG8_STAGE(PG8_SA(1, 0), a3, voffA);
            PG8_BAR; PG8_WAIT_L(0); PG8_MMA(1, 0, At, B0); PG8_BAR; PG8_SCHED;
            PG8_STAGE(PG8_SB(1, 1), b3 + hstep, voffB);
            PG8_WAIT_V(6); PG8_BAR; PG8_MMA(1, 1, At, B1); PG8_BAR;
            }
        }
        if constexpr (ALIGN_EPI) { if (wr == 0) PG8_BAR; }
        if constexpr (!Epi::AFTER_DRAIN) { E(acc, cur, wr, wc, fr, fq); S.done(cur); }
        if (!has_next) break;
#pragma unroll
        for (int a = 0; a < 2; ++a)
#pragma unroll
            for (int b = 0; b < 2; ++b)
#pragma unroll
                for (int m = 0; m < 4; ++m)
#pragma unroll
                    for (int n = 0; n < 2; ++n) acc[a][b][m][n] = (f32x4){0.f, 0.f, 0.f, 0.f};
        cur = nxt; cA = nA; cB = nB; ++ui;
        if constexpr (ALIGN_EPI) { if (wr == 1) PG8_BAR; }
    }
    PG8_WAIT_V(0);
    if constexpr (!ALIGN_EPI) { if (wr == 0) PG8_BAR; }
    PG8_BAR;
    if constexpr (Epi::AFTER_DRAIN) { E.fused(acc, cur, wr, wc, fr, fq, lds, wid, lane); S.done(cur); }
#undef PG8_SA
#undef PG8_SB
#undef PG8_STAGE
#undef PG8_LDA
#undef PG8_LDB
#undef PG8_MMA
#undef PG8_WAIT_V
#undef PG8_WAIT_L
#undef PG8_BAR
#undef PG8_SCHED
}
}
#define LAS __attribute__((address_space(3)))
typedef unsigned short bf16_t;
typedef short bf16x8 __attribute__((ext_vector_type(8)));
typedef short s16x4 __attribute__((ext_vector_type(4)));
typedef float f32x4 __attribute__((ext_vector_type(4)));
typedef float f32x16 __attribute__((ext_vector_type(16)));
typedef unsigned u32x4 __attribute__((ext_vector_type(4)));
typedef float f32x2_t __attribute__((ext_vector_type(2)));
typedef __bf16 bf16x2_t __attribute__((ext_vector_type(2)));
__device__ __forceinline__ unsigned pk2(float lo, float hi) { f32x2_t v = {lo, hi}; bf16x2_t b = __builtin_convertvector(v, bf16x2_t); return __builtin_bit_cast(unsigned, b); }
__device__ __forceinline__ float bf2f(unsigned short x) { return __uint_as_float((unsigned)x << 16); }
__device__ __forceinline__ float bflo(unsigned w) { return __uint_as_float(w << 16); }
__device__ __forceinline__ float bfhi(unsigned w) { return __uint_as_float(w & 0xffff0000u); }
__device__ __forceinline__ int crow(int r, int hi) { return (r & 3) + 8 * (r >> 2) + 4 * hi; }
__device__ __forceinline__ float wave_sum(float v) {
#pragma unroll
    for (int o = 1; o < 64; o <<= 1) v += __shfl_xor(v, o);
    return v;
}

#define GAS __attribute__((address_space(1)))
#define XB_TMO      128
#define XB_XCNT(j)  (256  + 64 * (j))
#define XB_XSUB(j)  (1280 + 64 * (j))
#define XB_XGEN(j)  (2304 + 64 * (j))
#define XB_TOP      3328
#define XB_TOPGEN   3392
#define XCD_BAR_WORDS 3456
#define XB_SPIN_CAP (1u << 18)

__device__ __forceinline__ unsigned xb_ld(unsigned* p)              { return __hip_atomic_load(p, __ATOMIC_RELAXED, __HIP_MEMORY_SCOPE_AGENT); }
__device__ __forceinline__ unsigned xb_add(unsigned* p, unsigned v) { return __hip_atomic_fetch_add(p, v, __ATOMIC_RELAXED, __HIP_MEMORY_SCOPE_AGENT); }
__device__ __forceinline__ unsigned xb_xcc_id() { return (unsigned)__builtin_amdgcn_s_getreg((3 << 11) | 20) & 0xFu; }
#define XB_SPIN(cond, bar) do { unsigned _sp = 0; while (cond) { __builtin_amdgcn_s_sleep(1); \
    if ((++_sp & 255u) == 0u) { if (xb_ld(&(bar)[XB_TMO])) break; if (_sp > XB_SPIN_CAP) { atomicAdd(&(bar)[XB_TMO], 1u); break; } } } } while (0)

struct XcdBarrier {
    unsigned* bar; unsigned x;
    volatile LAS unsigned* st;
};

__device__ __forceinline__ XcdBarrier xcd_barrier_post(unsigned* bar, volatile LAS unsigned* st) {
    XcdBarrier b; b.bar = bar; b.x = xb_xcc_id(); b.st = st;
    if (threadIdx.x == 0) (void)xb_add(&bar[XB_XCNT(b.x)], 1u);
    return b;
}
__device__ __forceinline__ void xcd_barrier_complete(unsigned* bar, unsigned x, unsigned& nloc, unsigned& nx) {
    const unsigned G = gridDim.x * gridDim.y * gridDim.z;
    unsigned sum, cnt, mine, sp = 0u;
    for (;;) {
        sum = 0u; cnt = 0u; mine = 0u;
#pragma unroll
        for (unsigned j = 0; j < 16; ++j) { const unsigned c = xb_ld(&bar[XB_XCNT(j)]); sum += c; cnt += (c > 0u) ? 1u : 0u; mine = (j == x) ? c : mine; }
        if (sum == G) break;
        __builtin_amdgcn_s_sleep(1);
        if ((++sp & 255u) == 0u) { if (xb_ld(&bar[XB_TMO])) break; if (sp > XB_SPIN_CAP) { atomicAdd(&bar[XB_TMO], 1u); break; } }
    }
    nloc = mine > 0u ? mine : 1u; nx = cnt > 0u ? cnt : 1u;
}

__device__ __forceinline__ void xcd_barrier(const XcdBarrier& b) {
    asm volatile("s_waitcnt vmcnt(0)" ::: "memory");
    __syncthreads();
    if (threadIdx.x == 0) {
        unsigned* bar = b.bar;
        __builtin_amdgcn_s_waitcnt(0);
        unsigned nloc = b.st[0], nx = b.st[1];
        if (nloc == 0u) { xcd_barrier_complete(bar, b.x, nloc, nx); b.st[0] = nloc; b.st[1] = nx; }
        const unsigned old = xb_add(&bar[XB_XSUB(b.x)], 1u);
        const unsigned gen = old / nloc;
        if (old + 1u == (gen + 1u) * nloc) {
            __builtin_amdgcn_fence(__ATOMIC_RELEASE, "agent");
            asm volatile("s_waitcnt vmcnt(0)" ::: "memory");
            const unsigned og = xb_add(&bar[XB_TOP], 1u);
            const unsigned tg = og / nx;
            if (og + 1u == (tg + 1u) * nx) xb_add(&bar[XB_TOPGEN], 1u);
            else XB_SPIN(xb_ld(&bar[XB_TOPGEN]) == tg, bar);
            __builtin_amdgcn_fence(__ATOMIC_ACQUIRE, "agent");
            xb_add(&bar[XB_XGEN(b.x)], 1u);
            asm volatile("s_waitcnt vmcnt(0)" ::: "memory");
        } else {
            XB_SPIN(xb_ld(&bar[XB_XGEN(b.x)]) == gen, bar);
            __builtin_amdgcn_fence(__ATOMIC_ACQUIRE, "agent");
            asm volatile("s_waitcnt vmcnt(0)" ::: "memory");
        }
    }
    __syncthreads();
}

struct Args { const float* in[19]; float* out; unsigned char* ws; };

__device__ __forceinline__ int perm_in0(int n) {
    if (n < 1024) { const int q8 = n >> 3, e = n & 7; return (e < 4) ? (4 * q8 + e) : (512 + 4 * q8 + (e - 4)); }
    if (n < 4096) { const int w = (n - 1024) & 63, hh = (n - 1024) >> 6, qq = w >> 3, e = w & 7; return 1024 + 64 * hh + 4 * qq + (e & 3) + ((e >= 4) ? 32 : 0); }
    return n;
}
__device__ __forceinline__ int perm_in1(int n) {
    if (n >= 512 && n < 1536) { const int mm = n - 512, q8 = mm >> 3, e = mm & 7; return (e < 4) ? (512 + 4 * q8 + e) : (1024 + 4 * q8 + (e - 4)); }
    return n;
}
struct TItem { const float* W; const float* kscale; bf16_t* WT; int K, N, perm, q; };
__device__ __forceinline__ int perm_any(int perm, int n) { return (perm == 1) ? perm_in0(n) : (perm == 2) ? perm_in1(n) : n; }
__device__ __forceinline__ void titem_load(const TItem& t, int lane, f32x4 (&v)[8]) {
    const int nblk = t.N / 32, kb = t.q / nblk, nb = t.q % nblk, k0 = 64 * kb, n0 = 32 * nb;
    const int kr = lane >> 3, n4 = lane & 7;
    const int ns = perm_any(t.perm, n0 + 4 * n4);
    const float* wp = t.W + (size_t)(k0 + kr) * t.N + ns;
#pragma unroll
    for (int i = 0; i < 8; ++i) v[i] = *(const f32x4*)(wp + (size_t)(8 * i) * t.N);
}
__device__ __forceinline__ void titem_finish(const TItem& t, int lane, const f32x4 (&v)[8], LAS float* scr) {
    const int nblk = t.N / 32, kb = t.q / nblk, nb = t.q % nblk, k0 = 64 * kb, n0 = 32 * nb;
    const int kr = lane >> 3, n4 = lane & 7;
#pragma unroll
    for (int i = 0; i < 8; ++i) { LAS float* d = scr + (kr + 8 * i) * 33 + 4 * n4; d[0] = v[i][0]; d[1] = v[i][1]; d[2] = v[i][2]; d[3] = v[i][3]; }
    asm volatile("s_waitcnt lgkmcnt(0)" ::: "memory");
    const int c = lane & 7;
    f32x4 ks0 = {1.f, 1.f, 1.f, 1.f}, ks1 = {1.f, 1.f, 1.f, 1.f};
    if (t.kscale) { ks0 = *(const f32x4*)(t.kscale + k0 + 8 * c); ks1 = *(const f32x4*)(t.kscale + k0 + 8 * c + 4); }
#pragma unroll
    for (int j = 0; j < 4; ++j) { const int n = (lane >> 3) + 8 * j; const LAS float* s = scr + (8 * c) * 33 + n;
        u32x4 o; o.x = pk2(s[0 * 33] * ks0[0], s[1 * 33] * ks0[1]); o.y = pk2(s[2 * 33] * ks0[2], s[3 * 33] * ks0[3]); o.z = pk2(s[4 * 33] * ks1[0], s[5 * 33] * ks1[1]); o.w = pk2(s[6 * 33] * ks1[2], s[7 * 33] * ks1[3]);
        *(u32x4*)(t.WT + (size_t)(n0 + n) * t.K + k0 + 8 * c) = o; }
    asm volatile("s_waitcnt lgkmcnt(0)" ::: "memory");
}

__device__ __forceinline__ s16x4 vtr(const LAS unsigned char* p) { typedef short v4i16_t __attribute__((ext_vector_type(4))); return __builtin_bit_cast(s16x4, __builtin_amdgcn_ds_read_tr16_b64_v4i16((LAS v4i16_t*)p)); }
__device__ __forceinline__ void attn_wave_unit(bf16_t* QK, const bf16_t* Vb, float* lse2, int b, int g, int h, int r, int i0, LAS unsigned char* vl, int lane) {
    const int dil = (g == 0) ? 1 : (g == 1 ? 4 : 16);
    const int hh = g * 8 + h, ql = lane & 31, hi = lane >> 5;
    const size_t rowbase = (size_t)b * SEQ + r;
    const bf16_t* qp = QK + (rowbase + (size_t)(i0 + ql) * dil) * 3072 + hh * 64 + hi * 8;
    bf16x8 qf[4];
#pragma unroll
    for (int s = 0; s < 4; ++s) qf[s] = *(const bf16x8*)(qp + 16 * s);
    bf16x8 kf[5][4];
#pragma unroll
    for (int j = 0; j < 5; ++j) {
        int kr = i0 - 128 + 32 * j + ql; kr = kr < 0 ? 0 : kr;
        const bf16_t* kp = QK + (rowbase + (size_t)kr * dil) * 3072 + 1536 + hh * 64 + hi * 8;
#pragma unroll
        for (int s = 0; s < 4; ++s) kf[j][s] = *(const bf16x8*)(kp + 16 * s);
    }
    u32x4 vr[5][4];
#pragma unroll
    for (int j = 0; j < 5; ++j)
#pragma unroll
        for (int i = 0; i < 4; ++i) { int rk = i0 - 128 + 32 * j + 8 * i + (lane >> 3); rk = rk < 0 ? 0 : rk;
            vr[j][i] = *(const u32x4*)(Vb + (rowbase + (size_t)rk * dil) * 1536 + hh * 64 + (lane & 7) * 8); }
    f32x16 S[5];
    const float NEG = -INFINITY;
#pragma unroll
    for (int j = 0; j < 5; ++j) {
        const bool tv = (i0 - 128 + 32 * j) >= 0;
        f32x16 acc = {};
#pragma unroll
        for (int s = 0; s < 4; ++s) acc = __builtin_amdgcn_mfma_f32_32x32x16_bf16(kf[j][s], qf[s], acc, 0, 0, 0);
#pragma unroll
        for (int rr = 0; rr < 16; ++rr) {
            bool ok = tv;
            if (j == 0) ok = ok && (crow(rr, hi) >= ql);
            if (j == 4) ok = ok && (crow(rr, hi) <= ql);
            acc[rr] = ok ? acc[rr] : NEG;
        }
        S[j] = acc;
    }
    float mx = NEG;
#pragma unroll
    for (int j = 0; j < 5; ++j)
#pragma unroll
        for (int rr = 0; rr < 16; ++rr) mx = fmaxf(mx, S[j][rr]);
    mx = fmaxf(mx, __shfl_xor(mx, 32));
    float l = 0.f;
#pragma unroll
    for (int j = 0; j < 5; ++j)
#pragma unroll
        for (int rr = 0; rr < 16; ++rr) { const float pe = __builtin_amdgcn_exp2f(S[j][rr] - mx); S[j][rr] = pe; l += pe; }
    l += __shfl_xor(l, 32);
    const float inv = 1.f / l;
    if (hi == 0) lse2[((size_t)g * M + rowbase + (size_t)(i0 + ql) * dil) * 8 + h] = mx + __builtin_amdgcn_logf(l);
    f32x16 O0 = {}, O1 = {};
    const int li = lane & 15, gq = li >> 2, gp = li & 3, chh = (lane >> 4) & 1;
#pragma unroll
    for (int j = 0; j < 5; ++j) {
        LAS unsigned char* vb_ = vl + (j & 1) * 4096;
#pragma unroll
        for (int i = 0; i < 4; ++i) *(LAS u32x4*)(vb_ + (8 * i + (lane >> 3)) * 128 + (lane & 7) * 16) = vr[j][i];
        asm volatile("s_waitcnt lgkmcnt(0)" ::: "memory");
#pragma unroll
        for (int s = 0; s < 2; ++s) {
            u32x4 pw;
            pw.x = pk2(S[j][8 * s + 0] * inv, S[j][8 * s + 1] * inv); pw.y = pk2(S[j][8 * s + 2] * inv, S[j][8 * s + 3] * inv);
            pw.z = pk2(S[j][8 * s + 4] * inv, S[j][8 * s + 5] * inv); pw.w = pk2(S[j][8 * s + 6] * inv, S[j][8 * s + 7] * inv);
            const bf16x8 pa = __builtin_bit_cast(bf16x8, pw);
#pragma unroll
            for (int db = 0; db < 2; ++db) {
                const LAS unsigned char* a1 = vb_ + (16 * s + 4 * hi + gq) * 128 + (32 * db + 16 * chh + 4 * gp) * 2;
                const s16x4 lo = vtr(a1), hv = vtr(a1 + 8 * 128);
                const bf16x8 vb = {lo[0], lo[1], lo[2], lo[3], hv[0], hv[1], hv[2], hv[3]};
                if (db == 0) O0 = __builtin_amdgcn_mfma_f32_32x32x16_bf16(pa, vb, O0, 0, 0, 0);
                else O1 = __builtin_amdgcn_mfma_f32_32x32x16_bf16(pa, vb, O1, 0, 0, 0);
            }
        }
    }
    asm volatile("s_waitcnt lgkmcnt(0)" ::: "memory");
#pragma unroll
    for (int rr = 0; rr < 16; ++rr) { const int q = crow(rr, hi);
        *(LAS bf16_t*)(vl + q * 128 + ql * 2) = (bf16_t)(pk2(O0[rr], 0.f) & 0xffffu);
        *(LAS bf16_t*)(vl + q * 128 + (32 + ql) * 2) = (bf16_t)(pk2(O1[rr], 0.f) & 0xffffu); }
    asm volatile("s_waitcnt lgkmcnt(0)" ::: "memory");
#pragma unroll
    for (int i = 0; i < 4; ++i) { const int rq = 8 * i + (lane >> 3), ch = lane & 7;
        const u32x4 v = *(const LAS u32x4*)(vl + rq * 128 + ch * 16);
        *(u32x4*)(QK + (rowbase + (size_t)(i0 + rq) * dil) * 3072 + hh * 64 + ch * 8) = v; }
    asm volatile("s_waitcnt lgkmcnt(0)" ::: "memory");
}

__device__ __forceinline__ float transpose_reduce32(float (&a)[32], int lane) {
#pragma unroll
    for (int n = 16; n >= 1; n >>= 1) {
        const bool bit = (lane & n) != 0;
#pragma unroll
        for (int i = 0; i < n; ++i) { const float lo = a[i], hv = a[i + n]; const float send = bit ? lo : hv, keep = bit ? hv : lo; a[i] = keep + __shfl_xor(send, n); }
    }
    return a[0] + __shfl_xor(a[0], 32);
}

__global__ void __launch_bounds__(512, 2) mk_fwd(Args args) {
    extern __shared__ __attribute__((aligned(16))) unsigned char lds_raw[];
    LAS unsigned char* lds = (LAS unsigned char*)lds_raw;
    const int tid = threadIdx.x, lane = tid & 63, wave = __builtin_amdgcn_readfirstlane(tid >> 6);
    const int G = gridDim.x, bx = blockIdx.x;
    const int vcu = (G % 8 == 0) ? (bx % 8) * (G / 8) + bx / 8 : bx;
    const int gw = vcu * 8 + wave, NGW = G * 8;
    const int gtid = bx * 512 + tid, NT = G * 512;
    unsigned char* ws = args.ws;
#if defined(PROBE_LO)
#define TSB ((unsigned long long*)(args.ws + 65536))
#define STAMP(k) do { if (blockIdx.x == 0 && threadIdx.x == 0) TSB[k] = __builtin_amdgcn_s_memrealtime(); } while (0)
    STAMP(0);
#else
#define STAMP(k) do {} while (0)
#endif
    for (int u = tid; u < (LDS_BYTES - 131072) / 4; u += 512) ((LAS unsigned*)(lds + 131072))[u] = 0u;
    __syncthreads();
    volatile LAS unsigned* MISC = (volatile LAS unsigned*)(lds + 131072 + 320);
    unsigned* ctl = (unsigned*)(ws + WS_CTL);
    const XcdBarrier bar = xcd_barrier_post(ctl, MISC + 8);
    const float* x = args.in[0];
    float* out = args.out;
    float* cs = (float*)(ws + WS_CS);
    float* ss = (float*)(ws + WS_SS);
    float* vst = (float*)(ws + WS_VST);
    float* lse2 = (float*)(ws + WS_LSE);
    bf16_t* Win0 = (bf16_t*)(ws + WS_WIN0); bf16_t* Wout0 = (bf16_t*)(ws + WS_WOUT0); bf16_t* W1_0 = (bf16_t*)(ws + WS_W1_0); bf16_t* W2_0 = (bf16_t*)(ws + WS_W2_0);
    bf16_t* Win1 = (bf16_t*)(ws + WS_WIN1); bf16_t* Wout1 = (bf16_t*)(ws + WS_WOUT1); bf16_t* W1_1 = (bf16_t*)(ws + WS_W1_1); bf16_t* W2_1 = (bf16_t*)(ws + WS_W2_1);
    bf16_t* R1 = (bf16_t*)(ws + WS_R1); bf16_t* GLU = (bf16_t*)(ws + WS_GLU); bf16_t* H1B = (bf16_t*)(ws + WS_H1B);
    bf16_t* QK = (bf16_t*)(ws + WS_QK); bf16_t* VB = (bf16_t*)(ws + WS_V); bf16_t* U = (bf16_t*)(ws + WS_U);
    bf16_t* GB = (bf16_t*)(ws + WS_GB); bf16_t* GG = (bf16_t*)(ws + WS_G); bf16_t* UB = (bf16_t*)(ws + WS_UB); bf16_t* VT = (bf16_t*)(ws + WS_VT); bf16_t* MIX1 = (bf16_t*)(ws + WS_MIX1);

    {
        for (int i = gtid; i < 4 * M + 2 * M; i += NT) { if (i < 4 * M) ss[M + i] = 0.f; else vst[i - 4 * M] = 0.f; }
        for (int i = gtid; i < SEQ * 32; i += NT) { const int s = i >> 5, f = i & 31; const float inv = powf(10000.0f, -(float)f / 32.0f); const float ang = (float)s * inv; float sn, c; sincosf(ang, &sn, &c); cs[2 * i] = c; cs[2 * i + 1] = sn; }
        { float* ckT = (float*)(ws + WS_CKT); const float* ck_ = args.in[4]; for (int i = gtid; i < 512 * 32; i += NT) { const int c_ = i >> 5, j_ = i & 31; ckT[i] = (j_ < 31) ? ck_[j_ * 512 + c_] : 0.f; } }
        LAS float* scr = (LAS float*)(lds + wave * 16384);
        constexpr int I_IN0 = 16 * (NIN0 / 32), I_OUT = 16 * 32, I_W1 = 16 * (FF / 32), I_W2 = 64 * 32, I_IN1 = 16 * (NIN1 / 32);
        constexpr int NITEMS = I_IN0 + I_OUT + I_W1 + I_W2 + I_IN1 + I_OUT + I_W1 + I_W2;
        auto decode = [&](int it) -> TItem {
            int q = it;
            if (q < I_IN0) return TItem{args.in[3], args.in[1], Win0, 1024, NIN0, 1, q}; q -= I_IN0;
            if (q < I_OUT) return TItem{args.in[8], nullptr, Wout0, 1024, 1024, 0, q}; q -= I_OUT;
            if (q < I_W1) return TItem{args.in[16], args.in[2], W1_0, 1024, FF, 0, q}; q -= I_W1;
            if (q < I_W2) return TItem{args.in[17], nullptr, W2_0, FF, 1024, 0, q}; q -= I_W2;
            if (q < I_IN1) return TItem{args.in[9], args.in[1] + 1024, Win1, 1024, NIN1, 2, q}; q -= I_IN1;
            if (q < I_OUT) return TItem{args.in[15], nullptr, Wout1, 1024, 1024, 0, q}; q -= I_OUT;
            if (q < I_W1) return TItem{args.in[16] + (size_t)1024 * FF, args.in[2] + 1024, W1_1, 1024, FF, 0, q}; q -= I_W1;
            return TItem{args.in[17] + (size_t)FF * 1024, nullptr, W2_1, FF, 1024, 0, q};
        };
        {
            int it = gw; f32x4 va[8], vb[8]; TItem ta{}, tb{};
            if (it < NITEMS) { ta = decode(it); titem_load(ta, lane, va); }
            while (it < NITEMS) {
                const int nx = it + NGW;
                if (nx < NITEMS) { tb = decode(nx); titem_load(tb, lane, vb); }
                titem_finish(ta, lane, va, scr);
                ta = tb;
#pragma unroll
                for (int i = 0; i < 8; ++i) va[i] = vb[i];
                it = nx;
            }
        }
        for (int row0 = gw * 4; row0 < M; row0 += NGW * 4) {
            f32x4 v[4][4];
#pragma unroll
            for (int rr = 0; rr < 4; ++rr)
#pragma unroll
                for (int j = 0; j < 4; ++j) v[rr][j] = ((const f32x4*)(x + (size_t)(row0 + rr) * 1024) + lane)[64 * j];
#pragma unroll
            for (int rr = 0; rr < 4; ++rr) { float sq = 0.f; unsigned long long* o8 = (unsigned long long*)(R1 + (size_t)(row0 + rr) * 1024) + lane;
#pragma unroll
                for (int j = 0; j < 4; ++j) { const f32x4 w = v[rr][j]; sq += (w[0] * w[0] + w[1] * w[1]) + (w[2] * w[2] + w[3] * w[3]); o8[64 * j] = (unsigned long long)pk2(w[0], w[1]) | ((unsigned long long)pk2(w[2], w[3]) << 32); }
                sq = wave_sum(sq); if (lane == 0) ss[row0 + rr] = sq; }
        }
    }
    xcd_barrier(bar);
    STAMP(1);
    {
        pg8::Gemm g{R1, Win0, M, NIN0, 1024}; pg8::StaticOrder S; S.init(M, NIN0, G, bx);
        pg8::EpiP p{}; p.ss = ss; p.o0 = GLU; p.o1 = QK; p.o2 = VB; p.cs = cs;
        pg8::Epi<0> E{p};
        pg8::gemm_phase<pg8::Epi<0>, pg8::StaticOrder, true, true>(lds, g, S, E);
    }
    xcd_barrier(bar);
    STAMP(2);
    {
#ifndef NO_ATTN
        for (int unit = vcu; unit < 256; unit += G) {
            const int b = unit >> 5, h = (unit >> 2) & 7, tb = unit & 3;
            LAS unsigned char* vl = lds + wave * 8192;
#pragma unroll 1
            for (int k = 0; k < 6; ++k) {
                const int wu = __builtin_amdgcn_readfirstlane(k * 8 + wave);
                const int g = wu >> 4, e = wu & 15;
                int r, i0;
                if (g == 0) { r = 0; i0 = tb * 512 + 32 * e; }
                else if (g == 1) { r = e & 3; i0 = tb * 128 + 32 * (e >> 2); }
                else { r = e; i0 = tb * 32; }
                attn_wave_unit(QK, VB, lse2, b, g, h, r, i0, vl, lane);
            }
            asm volatile("s_waitcnt vmcnt(0)" ::: "memory");
            __syncthreads();
            STAMP(20);
#pragma unroll 2
            for (int it = 0; it < 8; ++it) {
                const int tl = it * 64 + (tid >> 3), ch = tid & 7; const size_t row = (size_t)b * SEQ + tb * 512 + tl;
                const float l0 = lse2[((size_t)0 * M + row) * 8 + h], l1 = lse2[((size_t)1 * M + row) * 8 + h], l2 = lse2[((size_t)2 * M + row) * 8 + h];
                const float mxl = fmaxf(l0, fmaxf(l1, l2));
                float e0 = __builtin_amdgcn_exp2f(l0 - mxl), e1 = __builtin_amdgcn_exp2f(l1 - mxl), e2 = __builtin_amdgcn_exp2f(l2 - mxl);
                const float inv = 1.f / (e0 + e1 + e2); e0 *= inv; e1 *= inv; e2 *= inv;
                const u32x4 a0 = *(const u32x4*)(QK + row * 3072 + (0 + h) * 64 + ch * 8), a1 = *(const u32x4*)(QK + row * 3072 + (8 + h) * 64 + ch * 8), a2 = *(const u32x4*)(QK + row * 3072 + (16 + h) * 64 + ch * 8);
                u32x4 o;
#pragma unroll
                for (int w = 0; w < 4; ++w) o[w] = pk2(e0 * bflo(a0[w]) + e1 * bflo(a1[w]) + e2 * bflo(a2[w]), e0 * bfhi(a0[w]) + e1 * bfhi(a1[w]) + e2 * bfhi(a2[w]));
                *(u32x4*)(R1 + row * 1024 + 512 + h * 64 + ch * 8) = o;
            }
            __syncthreads();
        }
    STAMP(21);
#endif
#ifndef NO_CONV
        const float* cb = args.in[5]; const float* lg = args.in[6]; const float* lb = args.in[7];
        LAS float* part = (LAS float*)(lds + 65536); LAS float* stat = (LAS float*)(lds + 65536 + 4096);
        for (int tile = vcu; tile < 512; tile += G) {
            int tidc = threadIdx.x; asm volatile("" : "+v"(tidc));
            const int t0 = tile * 32, tseq = t0 & 2047;
            {
                const int ch = tidc & 63, r0 = tidc >> 6;
                const bf16_t* gp = GLU + (size_t)(t0 - 30 + r0) * 512 + ch * 8;
                LAS unsigned char* lp = lds + r0 * 1024 + ch * 16;
#pragma unroll
                for (int it = 0; it < 8; ++it) { const int rr = r0 + 8 * it;
                    if (rr < 62) { u32x4 v = {0u, 0u, 0u, 0u}; if (tseq - 30 + rr >= 0) v = *(const u32x4*)(gp + (size_t)it * 8 * 512); *(LAS u32x4*)(lp + it * 8192) = v; } }
            }
            __syncthreads();
            const int c = tidc;
            float o[32];
            {
                float kk[32];
                { const f32x4* kp4 = (const f32x4*)((const float*)(ws + WS_CKT) + c * 32);
#pragma unroll
                  for (int j4 = 0; j4 < 8; ++j4) { const f32x4 kq = kp4[j4]; kk[4 * j4] = kq[0]; kk[4 * j4 + 1] = kq[1]; kk[4 * j4 + 2] = kq[2]; kk[4 * j4 + 3] = kq[3]; } }
                const float bias = cb[c];
                float xv[62];
#pragma unroll
                for (int i = 0; i < 46; ++i) xv[i] = bf2f(*(const LAS bf16_t*)(lds + i * 1024 + c * 2));
#pragma unroll
                for (int t = 0; t < 16; ++t) { float acc = bias;
#pragma unroll
                    for (int j = 0; j < 31; ++j) acc += kk[j] * xv[t + j];
                    o[t] = acc; }
                asm volatile("" ::: "memory");
#pragma unroll
                for (int i = 46; i < 62; ++i) xv[i] = bf2f(*(const LAS bf16_t*)(lds + i * 1024 + c * 2));
#pragma unroll
                for (int t = 16; t < 32; ++t) { float acc = bias;
#pragma unroll
                    for (int j = 0; j < 31; ++j) acc += kk[j] * xv[t + j];
                    o[t] = acc; }
            }
            {
                float a[32];
#pragma unroll
                for (int t = 0; t < 32; ++t) a[t] = o[t];
                const float s1 = transpose_reduce32(a, lane);
#pragma unroll
                for (int t = 0; t < 32; ++t) a[t] = o[t] * o[t];
                const float s2 = transpose_reduce32(a, lane);
                if (lane < 32) { part[(lane * 8 + wave) * 2] = s1; part[(lane * 8 + wave) * 2 + 1] = s2; }
            }
            __syncthreads();
            if (tidc < 32) { float s1 = 0.f, s2 = 0.f;
#pragma unroll
                for (int w = 0; w < 8; ++w) { s1 += part[(tidc * 8 + w) * 2]; s2 += part[(tidc * 8 + w) * 2 + 1]; }
                const float mean = s1 * (1.f / 512.f), var = s2 * (1.f / 512.f) - mean * mean;
                stat[2 * tidc] = mean; stat[2 * tidc + 1] = rsqrtf(fmaxf(var, 0.f) + EPS); }
            __syncthreads();
            const float lgc = lg[c], lbc = lb[c];
#pragma unroll
            for (int t = 0; t < 32; ++t) { const float mean = stat[2 * t], rstd = stat[2 * t + 1]; const float y = (o[t] - mean) * rstd * lgc + lbc; const float a = y * pg8::sigm(y);
                *(LAS bf16_t*)(lds + t * 1024 + c * 2) = (bf16_t)(pk2(a, 0.f) & 0xffffu); }
            __syncthreads();
            for (int idx = tidc; idx < 32 * 64; idx += 512) { const int rr = idx >> 6, ch = idx & 63; const u32x4 v = *(const LAS u32x4*)(lds + rr * 1024 + ch * 16); *(u32x4*)(R1 + (size_t)(t0 + rr) * 1024 + ch * 8) = v; }
            __syncthreads();
        }
#endif
    }
    xcd_barrier(bar);
    STAMP(3);
    {
        pg8::Gemm g{R1, Wout0, M, 1024, 1024}; pg8::StaticOrder S; S.init(M, 1024, G, bx);
        pg8::EpiP p{}; p.resid = x; p.hout = out; p.hb = H1B; p.ss_out = ss + M;
        pg8::Epi<1> E{p};
        pg8::gemm_phase<pg8::Epi<1>, pg8::StaticOrder, true, true>(lds, g, S, E);
    }
    xcd_barrier(bar);
    STAMP(4);
    {
        pg8::Gemm g{H1B, W1_0, M, FF, 1024}; pg8::StaticOrder S; S.init(M, FF, G, bx);
        pg8::EpiP p{}; p.ss = ss + M; p.o0 = U;
        pg8::Epi<2> E{p};
        pg8::gemm_phase<pg8::Epi<2>, pg8::StaticOrder, true, true>(lds, g, S, E);
    }
    xcd_barrier(bar);
    STAMP(5);
    {
        pg8::Gemm g{U, W2_0, M, 1024, FF}; pg8::StaticOrder S; S.init(M, 1024, G, bx);
        pg8::EpiP p{}; p.resid = out; p.hout = out; p.hb = R1; p.ss_out = ss + 2 * M;
        pg8::Epi<1> E{p};
        pg8::gemm_phase<pg8::Epi<1>, pg8::StaticOrder, true, true>(lds, g, S, E);
    }
    xcd_barrier(bar);
    STAMP(6);
    {
        pg8::Gemm g{R1, Win1, M, NIN1, 1024}; pg8::StaticOrder S; S.init(M, NIN1, G, bx);
        pg8::EpiP p{}; p.ss = ss + 2 * M; p.o0 = GB; p.o1 = GG; p.o2 = UB; p.o3 = VT; p.vst = vst;
        pg8::Epi<3> E{p};
        pg8::gemm_phase<pg8::Epi<3>, pg8::StaticOrder, true, true>(lds, g, S, E);
    }
    xcd_barrier(bar);
    STAMP(7);
    {
        const float* sk = args.in[10]; const float* lg = args.in[11]; const float* lb = args.in[12]; const float* sgw = args.in[13]; const float* sgb = args.in[14];
        for (int idx = gtid; idx < M * 64; idx += NT) {
            const int row = idx >> 6, ch = idx & 63, tseq = row & 2047;
            const u32x4 gbv = *(const u32x4*)(GB + (size_t)row * 512 + ch * 8);
            float acc[8];
#pragma unroll
            for (int e = 0; e < 8; ++e) acc[e] = 0.f;
#pragma unroll
            for (int j = 0; j < 3; ++j) {
                if (tseq - 2 + j >= 0) {
                    const u32x4 gv = *(const u32x4*)(GG + (size_t)(row - 2 + j) * 512 + ch * 8);
                    const f32x4 k0 = *(const f32x4*)(sk + j * 512 + ch * 8), k1 = *(const f32x4*)(sk + j * 512 + ch * 8 + 4);
                    acc[0] += k0[0] * bflo(gv[0]); acc[1] += k0[1] * bfhi(gv[0]); acc[2] += k0[2] * bflo(gv[1]); acc[3] += k0[3] * bfhi(gv[1]);
                    acc[4] += k1[0] * bflo(gv[2]); acc[5] += k1[1] * bfhi(gv[2]); acc[6] += k1[2] * bflo(gv[3]); acc[7] += k1[3] * bfhi(gv[3]);
                }
            }
            u32x4 o;
#pragma unroll
            for (int w = 0; w < 4; ++w) o[w] = pk2(bflo(gbv[w]) * acc[2 * w], bfhi(gbv[w]) * acc[2 * w + 1]);
            *(u32x4*)(MIX1 + (size_t)row * 1024 + ch * 8) = o;
        }
#ifndef NO_SGU
        LAS float* RS = (LAS float*)lds; LAS float* MU = RS + 128; LAS float* RHO = RS + 256; LAS float* SIG = RS + 384;
        const int ql = lane & 31, hi = lane >> 5;
        for (int unit = vcu; unit < 512; unit += G) {
            const int n = unit >> 2, gi = unit & 3, tok0 = n * 128;
            if (tid < 128) { const float sm = vst[2 * (tok0 + tid)], sq = vst[2 * (tok0 + tid) + 1]; const float mean = sm * (1.f / 512.f), var = sq * (1.f / 512.f) - mean * mean;
                RS[tid] = rsqrtf(fmaxf(var, 0.f) + EPS); MU[tid] = mean; }
            __syncthreads();
            if (tid < 128) { const float* wr_ = sgw + ((size_t)gi * 128 + tid) * 128; float sg = 0.f, rho = 0.f;
                for (int s = 0; s <= tid; ++s) { const float w = wr_[s]; sg += w; rho += w * RS[s] * MU[s]; }
                RHO[tid] = rho; SIG[tid] = sg; }
            const int tr = wave >> 1, tc0 = (wave & 1) * 2;
            f32x16 D0 = {}, D1 = {};
            const int t = 32 * tr + ql;
            const float* wp = sgw + ((size_t)gi * 128 + t) * 128 + 8 * hi;
            const bf16_t* vp0 = VT + ((size_t)gi * 128 + 32 * tc0 + ql) * M + tok0 + 8 * hi;
            const bf16_t* vp1 = vp0 + (size_t)32 * M;
            for (int s0 = 0; s0 < 32 * (tr + 1); s0 += 16) {
                const f32x4 w0 = *(const f32x4*)(wp + s0), w1 = *(const f32x4*)(wp + s0 + 4);
                float av[8];
#pragma unroll
                for (int j = 0; j < 4; ++j) { av[j] = w0[j]; av[j + 4] = w1[j]; }
#pragma unroll
                for (int j = 0; j < 8; ++j) { const int s = s0 + 8 * hi + j; av[j] = (s <= t) ? av[j] * RS[s] : 0.f; }
                u32x4 aw; aw.x = pk2(av[0], av[1]); aw.y = pk2(av[2], av[3]); aw.z = pk2(av[4], av[5]); aw.w = pk2(av[6], av[7]);
                const bf16x8 af = __builtin_bit_cast(bf16x8, aw);
                const bf16x8 b0 = *(const bf16x8*)(vp0 + s0), b1 = *(const bf16x8*)(vp1 + s0);
                D0 = __builtin_amdgcn_mfma_f32_32x32x16_bf16(af, b0, D0, 0, 0, 0);
                D1 = __builtin_amdgcn_mfma_f32_32x32x16_bf16(af, b1, D1, 0, 0, 0);
            }
            __syncthreads();
#pragma unroll
            for (int q = 0; q < 2; ++q) {
                const int chn = gi * 128 + 32 * (tc0 + q) + ql; const float lgc = lg[chn], lbc = lb[chn];
#pragma unroll
                for (int rr = 0; rr < 16; ++rr) { const int tt = 32 * tr + crow(rr, hi); const size_t token = (size_t)tok0 + tt;
                    const float dv = (q == 0) ? D0[rr] : D1[rr];
                    const float val = lgc * (dv - RHO[tt]) + lbc * SIG[tt] + sgb[gi * 128 + tt];
                    const float uu = bf2f(UB[token * 512 + chn]);
                    MIX1[token * 1024 + 512 + chn] = (bf16_t)(pk2(uu * val, 0.f) & 0xffffu); }
            }
            __syncthreads();
        }
#endif
    }
    xcd_barrier(bar);
    STAMP(8);
    {
        pg8::Gemm g{MIX1, Wout1, M, 1024, 1024}; pg8::StaticOrder S; S.init(M, 1024, G, bx);
        pg8::EpiP p{}; p.resid = out; p.hout = out; p.hb = R1; p.ss_out = ss + 3 * M;
        pg8::Epi<1> E{p};
        pg8::gemm_phase<pg8::Epi<1>, pg8::StaticOrder, true, true>(lds, g, S, E);
    }
    xcd_barrier(bar);
    STAMP(9);
    {
        pg8::Gemm g{R1, W1_1, M, FF, 1024}; pg8::StaticOrder S; S.init(M, FF, G, bx);
        pg8::EpiP p{}; p.ss = ss + 3 * M; p.o0 = U;
        pg8::Epi<2> E{p};
        pg8::gemm_phase<pg8::Epi<2>, pg8::StaticOrder, true, true>(lds, g, S, E);
    }
    xcd_barrier(bar);
    STAMP(10);
    {
        pg8::Gemm g{U, W2_1, M, 1024, FF}; pg8::StaticOrder S; S.init(M, 1024, G, bx);
        pg8::EpiP p{}; p.resid = out; p.hout = out; p.hb = nullptr; p.ss_out = ss + 4 * M;
        pg8::Epi<1> E{p};
        pg8::gemm_phase<pg8::Epi<1>, pg8::StaticOrder, true, true>(lds, g, S, E);
    }
    xcd_barrier(bar);
    STAMP(11);
    {
        const float* fg = args.in[18];
        for (int row = gw; row < M; row += NGW) {
            const float r = rsqrtf(ss[4 * M + row] * (1.f / 1024.f) + EPS);
            f32x4* orow = (f32x4*)(out + (size_t)row * 1024) + lane; const f32x4* gr = (const f32x4*)fg + lane;
#pragma unroll
            for (int j = 0; j < 4; ++j) { const f32x4 v = orow[64 * j]; orow[64 * j] = v * r * gr[64 * j]; }
        }
    }
#if defined(PROBE_LO)
    xcd_barrier(bar);
    STAMP(12);
    xcd_barrier(bar);
    {
        const float XA = (float)(TSB[PROBE_HI] - TSB[PROBE_LO]) * 0.01f, YB = 0.f;
        float* o_ = args.out; const int g_ = blockIdx.x * 512 + threadIdx.x, n_ = gridDim.x * 512;
        (void)n_; (void)YB;
        if (g_ == 0) o_[0] = XA;
    }
#endif
}

extern "C" void kernel_launch(void* const* d_in, const int* in_sizes, int n_in, void* d_out, int out_size, void* d_ws, size_t ws_size, hipStream_t stream) {
    static int grid = 0;
    if (grid == 0) {
        if (n_in != 19 || out_size != M * DM || ws_size < WS_END) { fprintf(stderr, "kernel_launch: unexpected shapes (n_in %d out %d ws %zu)\n", n_in, out_size, ws_size); grid = -1; return; }
        int dev = 0, cus = 0, per_cu = 0;
        hipGetDevice(&dev); hipDeviceGetAttribute(&cus, hipDeviceAttributeMultiprocessorCount, dev);
        if (hipFuncSetAttribute((const void*)mk_fwd, hipFuncAttributeMaxDynamicSharedMemorySize, LDS_BYTES) != hipSuccess) { fprintf(stderr, "kernel_launch: hipFuncSetAttribute failed\n"); grid = -1; return; }
        if (hipOccupancyMaxActiveBlocksPerMultiprocessor(&per_cu, (const void*)mk_fwd, 512, LDS_BYTES) != hipSuccess || per_cu < 1) { fprintf(stderr, "kernel_launch: occupancy query says %d\n", per_cu); per_cu = 1; }
        (void)hipGetLastError();
        grid = cus;
        fprintf(stderr, "kernel_launch: cus %d per_cu %d grid %d\n", cus, per_cu, grid);
    }
    if (grid < 0) return;
    Args a{};
    for (int i = 0; i < 19; ++i) a.in[i] = (const float*)d_in[i];
    a.out = (float*)d_out; a.ws = (unsigned char*)d_ws;
    if (hipMemsetAsync((char*)d_ws + WS_CTL, 0, 16384, stream) != hipSuccess) { fprintf(stderr, "kernel_launch: memset failed\n"); return; }
    hipLaunchKernelGGL(mk_fwd, dim3(grid), dim3(512), LDS_BYTES, stream, a);
    hipError_t e = hipPeekAtLastError();
    if (e != hipSuccess) fprintf(stderr, "launch failed: %s (grid %d)\n", hipGetErrorString(e), grid);
}
```

```cpp
#include <hip/hip_runtime.h>
#include <hip/hip_cooperative_groups.h>
#include <cstdio>
#include <cstdint>
namespace cg = cooperative_groups;

#ifndef MK_CHECK
#define MK_CHECK 0
#endif

constexpr int M = 16384, DM = 1024, SEQ = 2048, NIN0 = 5632, NIN1 = 2560, FF = 4096;
constexpr float EPS = 1e-6f;
constexpr float QSCALE = 0.125f * 1.4426950408889634f;
constexpr size_t MiB = 1u << 20;
constexpr size_t WS_CTL = 0;
constexpr size_t WS_CS = 1 * MiB;
constexpr size_t WS_SS = WS_CS + 512 * 1024;
constexpr size_t WS_VST = WS_SS + 5 * M * 4;
constexpr size_t WS_CKT = WS_VST + 2 * M * 4;
constexpr size_t WS_LSE = 2 * MiB;
constexpr size_t WS_W = 4 * MiB;
constexpr size_t WS_WIN0 = WS_W, WS_WOUT0 = WS_WIN0 + 11 * MiB, WS_W1_0 = WS_WOUT0 + 2 * MiB, WS_W2_0 = WS_W1_0 + 8 * MiB;
constexpr size_t WS_WIN1 = WS_W2_0 + 8 * MiB, WS_WOUT1 = WS_WIN1 + 5 * MiB, WS_W1_1 = WS_WOUT1 + 2 * MiB, WS_W2_1 = WS_W1_1 + 8 * MiB;
constexpr size_t WS_R1 = 56 * MiB;
constexpr size_t WS_GLU = 88 * MiB;
constexpr size_t WS_H1B = 88 * MiB;
constexpr size_t WS_QK = 104 * MiB;
constexpr size_t WS_V = 200 * MiB;
constexpr size_t WS_U = 120 * MiB;
constexpr size_t WS_GB = 88 * MiB, WS_G = 104 * MiB, WS_UB = 120 * MiB, WS_VT = 136 * MiB, WS_MIX1 = 152 * MiB;
constexpr size_t WS_END = 248 * MiB;
static_assert(WS_W2_1 + 8 * MiB == WS_R1, "weights end at R1");
constexpr int LDS_BYTES = 147456;

namespace pg8 {
#define PG8_LAS __attribute__((address_space(3)))
typedef unsigned short bf16_t;
typedef short bf16x8 __attribute__((ext_vector_type(8)));
typedef float f32x4 __attribute__((ext_vector_type(4)));
typedef unsigned u32x4 __attribute__((ext_vector_type(4)));
constexpr int BM = 256, BK = 64, HALF = 128, HTB = HALF * BK * 2  , STAGE_BYTES = 8 * HTB, NXCD = 8, WGM = 8;

__host__ __device__ __forceinline__ int lds_byte(int r, int c) { const int st = (r >> 4) * 2 + (c >> 5), rr = r & 15, cc = c & 31, ob = rr * 64 + cc * 2; return st * 1024 + (ob ^ (((ob >> 9) & 1) << 5)); }
__host__ __device__ __forceinline__ void stage_rc(int b, int& R, int& C) { const int st = b / 1024, sb = b % 1024, swz = sb ^ (((sb >> 9) & 1) << 5); R = (st >> 1) * 16 + swz / 64; C = (st & 1) * 32 + (swz % 64) / 2; }
__host__ __device__ __forceinline__ int perm32(int rho) { const int n = rho >> 4, i = rho & 15; return 8 * (i >> 2) + 4 * n + (i & 3); }

struct Unit { int pm, pn; };
struct Gemm { const bf16_t* A; const bf16_t* Bt; int M, N, K; };

struct StaticOrder {
    int nM, nN, nwg, G, c;
    __host__ __device__ void init(int M, int N, int G_, int c_) { nM = M / BM; nN = N / BM; nwg = nM * nN; G = G_; c = c_; }
    __host__ __device__ bool next(int i, Unit& u) const {
        const long L = (long)i * G + c; if (L >= nwg) return false;
        int wgid = (int)L; { const int q = nwg / NXCD, r = nwg % NXCD, xcd = wgid % NXCD, off = wgid / NXCD; wgid = (xcd < r ? xcd * (q + 1) : r * (q + 1) + (xcd - r) * q) + off; }
        const int nig = WGM * nN, gid = wgid / nig, fm = gid * WGM, gsz = (nM - fm) < WGM ? (nM - fm) : WGM;
        u.pm = fm + ((wgid % nig) % gsz); u.pn = (wgid % nig) / gsz; return true;
    }
    __device__ __forceinline__ void a_ready(const Unit&) const {}
    __device__ __forceinline__ void done(const Unit&) const {}
};

__device__ __forceinline__ unsigned cvt_pk_bf16(float lo, float hi) { unsigned r; asm volatile("v_cvt_pk_bf16_f32 %0, %1, %2" : "=v"(r) : "v"(lo), "v"(hi)); return r; }
typedef float f32x2 __attribute__((ext_vector_type(2)));
typedef unsigned u32x2 __attribute__((ext_vector_type(2)));
__device__ __forceinline__ void store8(bf16_t* p, const f32x4& a, const f32x4& b) { u32x4 w; w.x = cvt_pk_bf16(a[0], a[1]); w.y = cvt_pk_bf16(a[2], a[3]); w.z = cvt_pk_bf16(b[0], b[1]); w.w = cvt_pk_bf16(b[2], b[3]); *(u32x4*)p = w; }
__device__ __forceinline__ void store4(bf16_t* p, const f32x4& a) { u32x2 w; w.x = cvt_pk_bf16(a[0], a[1]); w.y = cvt_pk_bf16(a[2], a[3]); *(u32x2*)p = w; }
__device__ __forceinline__ float sigm(float x) { return __builtin_amdgcn_rcpf(1.f + __expf(-x)); }
__device__ __forceinline__ float gelu_t(float x) { const float t = 1.5957691216057308f * (x + 0.044715f * x * x * x); return x * sigm(t); }
struct EpiP {
    const float* ss; float* ss_out; const float* resid; float* hout; bf16_t* hb;
    bf16_t* o0; bf16_t* o1; bf16_t* o2; bf16_t* o3; const float* cs; float* vst;
};
template <int KIND> struct Epi {
    static constexpr bool PERM = true, AFTER_DRAIN = false;
    EpiP p;
    __device__ __forceinline__ void operator()(const f32x4 (&acc)[2][2][4][2], const Unit& u, int wr, int wc, int fr, int fq) const {
        const int colt = u.pn * BM + wc * 32 + 8 * fq;
#pragma unroll
        for (int ai = 0; ai < 2; ++ai)
#pragma unroll
            for (int m = 0; m < 4; ++m) {
                const int row = u.pm * BM + ai * HALF + wr * 64 + m * 16 + fr;
                float r = 1.f;
                if (KIND != 1 && KIND != 4) r = rsqrtf(p.ss[row] * (1.f / 1024.f) + 1e-6f);
                float sq = 0.f, s1 = 0.f;
#pragma unroll
                for (int bj = 0; bj < 2; ++bj) {
                    const int c0 = colt + bj * HALF;
                    f32x4 v0 = acc[ai][bj][m][0] * r, v1 = acc[ai][bj][m][1] * r;
                    if (KIND == 0) {
                        if (u.pn < 4) {
                            f32x4 o;
#pragma unroll
                            for (int j = 0; j < 4; ++j) o[j] = v0[j] * sigm(v1[j]);
                            store4(p.o0 + (size_t)row * 512 + (c0 >> 1), o);
                        } else if (u.pn < 16) {
                            const int qq = ((c0 - 1024) & 63) >> 3, pos = row & 2047;
                            const f32x4* t = (const f32x4*)(p.cs + ((size_t)pos * 32 + 4 * qq) * 2);
                            const f32x4 t0 = t[0], t1 = t[1];
                            const f32x4 cc = {t0[0], t0[2], t1[0], t1[2]}, sn = {t0[1], t0[3], t1[1], t1[3]};
                            f32x4 o1 = v0 * cc - v1 * sn, o2 = v1 * cc + v0 * sn;
                            if (u.pn < 10) { o1 = o1 * QSCALE; o2 = o2 * QSCALE; }
                            store8(p.o1 + (size_t)row * 3072 + (c0 - 1024), o1, o2);
                        } else {
                            store8(p.o2 + (size_t)row * 1536 + (c0 - 4096), v0, v1);
                        }
                    } else if (KIND == 1 || KIND == 4) {
                        const size_t off = (size_t)row * 1024 + c0;
                        if (KIND == 1) { const f32x4 r0 = *(const f32x4*)(p.resid + off), r1 = *(const f32x4*)(p.resid + off + 4); v0 = v0 + r0; v1 = v1 + r1; }
                        else { const u32x4 rb = *(const u32x4*)(p.hb + off);
                            v0[0] += __uint_as_float(rb.x << 16); v0[1] += __uint_as_float(rb.x & 0xffff0000u); v0[2] += __uint_as_float(rb.y << 16); v0[3] += __uint_as_float(rb.y & 0xffff0000u);
                            v1[0] += __uint_as_float(rb.z << 16); v1[1] += __uint_as_float(rb.z & 0xffff0000u); v1[2] += __uint_as_float(rb.w << 16); v1[3] += __uint_as_float(rb.w & 0xffff0000u); }
                        store8(p.o0 + off, v0, v1);
#pragma unroll
                        for (int j = 0; j < 4; ++j) sq += v0[j] * v0[j] + v1[j] * v1[j];
                    } else if (KIND == 2) {
#pragma unroll
                        for (int j = 0; j < 4; ++j) { float a = fmaxf(v0[j], 0.f), b = fmaxf(v1[j], 0.f); v0[j] = a * a; v1[j] = b * b; }
                        store8(p.o0 + (size_t)row * 4096 + c0, v0, v1);
                    } else {
                        if (u.pn < 2) store8(p.o0 + (size_t)row * 512 + c0, v0, v1);
                        else if (u.pn < 6) { const f32x4 o = v0 * v1; store4(p.o1 + (size_t)row * 512 + ((c0 - 512) >> 1), o); }
                        else if (u.pn < 8) {
#pragma unroll
                            for (int j = 0; j < 4; ++j) { v0[j] = gelu_t(v0[j]); v1[j] = gelu_t(v1[j]); }
                            store8(p.o2 + (size_t)row * 512 + (c0 - 1536), v0, v1);
                        } else {
                            bf16_t* vt = p.o3 + (size_t)(c0 - 2048) * ::M + row;
#pragma unroll
                            for (int j = 0; j < 4; ++j) { v0[j] = gelu_t(v0[j]); v1[j] = gelu_t(v1[j]); s1 += v0[j] + v1[j]; sq += v0[j] * v0[j] + v1[j] * v1[j]; }
#pragma unroll
                            for (int j = 0; j < 4; ++j) { vt[(size_t)j * ::M] = (bf16_t)(cvt_pk_bf16(v0[j], 0.f) & 0xffffu); vt[(size_t)(j + 4) * ::M] = (bf16_t)(cvt_pk_bf16(v1[j], 0.f) & 0xffffu); }
                        }
                    }
                }
                if (KIND == 1 || KIND == 4) {
                    sq += __shfl_xor(sq, 16); sq += __shfl_xor(sq, 32);
                    if (fq == 0) atomicAdd(p.ss_out + row, sq);
                }
                if (KIND == 3) {
                    if (u.pn >= 8) {
                        sq += __shfl_xor(sq, 16); sq += __shfl_xor(sq, 32); s1 += __shfl_xor(s1, 16); s1 += __shfl_xor(s1, 32);
                        if (fq == 0) { atomicAdd(p.vst + 2 * row, s1); atomicAdd(p.vst + 2 * row + 1, sq); }
                    }
                }
            }
    }
};
template <class Epi, class Sched, bool ALIGN_EPI = false, bool SP2 = false>
__device__ __forceinline__ void gemm_phase(PG8_LAS unsigned char* lds, const Gemm g, const Sched& S, const Epi& E) {
    int tid_ = threadIdx.x; asm volatile("" : "+v"(tid_));
    const int tid = tid_, wid = __builtin_amdgcn_readfirstlane(tid >> 6), lane = tid & 63, wr = wid >> 2, wc = wid & 3, fr = lane & 15, fq = lane >> 4;
    const int K = g.K, nt = K / BK;
    unsigned voffA[2], voffB[2];
#pragma unroll
    for (int i = 0; i < 2; ++i) { int R, C; stage_rc(tid * 16 + i * 8192, R, C); const int Rb = Epi::PERM ? ((R & ~31) + perm32(R & 31)) : R;
        voffA[i] = (unsigned)(R * K + C) * 2u; voffB[i] = (unsigned)(Rb * K + C) * 2u; }
    const size_t kstep = (size_t)(BK * 2);
    const size_t hstep = (size_t)HALF * K * 2;
    const size_t tstep = 2 * hstep;
    const unsigned ldsw = (unsigned)wid * 1024u;
    const int aoff = lds_byte(wr * 64 + fr, fq * 8), boff = lds_byte(wc * 32 + fr, fq * 8);
#define PG8_SA(b, h) (((b) * 2 + (h)) * HTB)
#define PG8_SB(b, h) ((4 + (b) * 2 + (h)) * HTB)
#define PG8_STAGE(bufoff, gbase, voff) do { _Pragma("unroll") for (int _i = 0; _i < 2; ++_i) \
        __builtin_amdgcn_global_load_lds((const unsigned*)((const char*)(gbase) + (voff)[_i]), (PG8_LAS unsigned*)(lds + (bufoff) + ldsw + _i * 8192), 16, 0, 0); } while (0)
#define PG8_LDA(dst, b, h) do { _Pragma("unroll") for (int m = 0; m < 4; ++m) _Pragma("unroll") for (int k = 0; k < 2; ++k) dst[m][k] = *(const PG8_LAS bf16x8*)(lds + PG8_SA(b, h) + aoff + m * 2048 + k * 1024); } while (0)
#define PG8_LDB(dst, b, h) do { _Pragma("unroll") for (int n = 0; n < 2; ++n) _Pragma("unroll") for (int k = 0; k < 2; ++k) dst[n][k] = *(const PG8_LAS bf16x8*)(lds + PG8_SB(b, h) + boff + n * 2048 + k * 1024); } while (0)
#define PG8_MMA(ai, bj, At, Bt) do { __builtin_amdgcn_s_setprio(1); _Pragma("unroll") for (int m = 0; m < 4; ++m) _Pragma("unroll") for (int n = 0; n < 2; ++n) _Pragma("unroll") for (int k = 0; k < 2; ++k) \
        acc[ai][bj][m][n] = __builtin_amdgcn_mfma_f32_16x16x32_bf16(Bt[n][k], At[m][k], acc[ai][bj][m][n], 0, 0, 0); __builtin_amdgcn_s_setprio(0); } while (0)
#define PG8_WAIT_V(n) asm volatile("s_waitcnt vmcnt(" #n ")" ::: "memory")
#define PG8_WAIT_L(n) asm volatile("s_waitcnt lgkmcnt(" #n ")" ::: "memory")
#define PG8_BAR __builtin_amdgcn_s_barrier()
#define PG8_SCHED __builtin_amdgcn_sched_barrier(0)
    Unit cur, nxt; int ui = 0;
    if (!S.next(0, cur)) return;
    f32x4 acc[2][2][4][2];
#pragma unroll
    for (int a = 0; a < 2; ++a)
#pragma unroll
        for (int b = 0; b < 2; ++b)
#pragma unroll
            for (int m = 0; m < 4; ++m)
#pragma unroll
                for (int n = 0; n < 2; ++n) acc[a][b][m][n] = (f32x4){0.f, 0.f, 0.f, 0.f};
    bf16x8 At[4][2], B0[2][2], B1[2][2];
    const char* cA = (const char*)g.A + (size_t)cur.pm * tstep; const char* cB = (const char*)g.Bt + (size_t)cur.pn * tstep;
    S.a_ready(cur);
    if constexpr (SP2) {
        PG8_STAGE(PG8_SB(0, 0), cB, voffB); PG8_STAGE(PG8_SB(0, 1), cB + hstep, voffB); PG8_STAGE(PG8_SA(0, 0), cA, voffA); PG8_STAGE(PG8_SA(0, 1), cA + hstep, voffA);
        if (wr == 1) PG8_BAR;
        PG8_WAIT_V(2); PG8_BAR;
        PG8_STAGE(PG8_SB(1, 0), cB + kstep, voffB); PG8_STAGE(PG8_SA(1, 0), cA + kstep, voffA); PG8_STAGE(PG8_SB(1, 1), cB + hstep + kstep, voffB);
        PG8_WAIT_V(6); PG8_BAR;
    } else {
        PG8_STAGE(PG8_SB(0, 0), cB, voffB); PG8_STAGE(PG8_SA(0, 0), cA, voffA); PG8_STAGE(PG8_SB(0, 1), cB + hstep, voffB); PG8_STAGE(PG8_SA(0, 1), cA + hstep, voffA);
        if (wr == 1) PG8_BAR;
        PG8_WAIT_V(4); PG8_BAR;
        PG8_STAGE(PG8_SB(1, 0), cB + kstep, voffB); PG8_STAGE(PG8_SA(1, 0), cA + kstep, voffA); PG8_STAGE(PG8_SB(1, 1), cB + hstep + kstep, voffB);
        PG8_WAIT_V(6); PG8_BAR;
    }
    for (;;) {
        const bool has_next = S.next(ui + 1, nxt);
        const char* nA = has_next ? (const char*)g.A + (size_t)nxt.pm * tstep : cA; const char* nB = has_next ? (const char*)g.Bt + (size_t)nxt.pn * tstep : cB;
        for (int t = 0; t < nt; t += 2) {
            const bool last = (t == nt - 2);
            const char* a1 = cA + (size_t)(t + 1) * kstep;
            const char* a2 = last ? nA : cA + (size_t)(t + 2) * kstep; const char* b2 = last ? nB : cB + (size_t)(t + 2) * kstep;
            const char* a3 = a2 + kstep; const char* b3 = b2 + kstep;
            if (last && has_next) S.a_ready(nxt);
            if constexpr (SP2) {
            PG8_LDB(B0, 0, 0); PG8_LDB(B1, 0, 1); PG8_SCHED; PG8_LDA(At, 0, 0); PG8_STAGE(PG8_SA(1, 1), a1 + hstep, voffA);
            PG8_WAIT_V(8); PG8_WAIT_L(0); PG8_BAR; PG8_MMA(0, 0, At, B0); PG8_MMA(0, 1, At, B1); PG8_BAR; PG8_SCHED;
            PG8_LDA(At, 0, 1); PG8_STAGE(PG8_SB(0, 0), b2, voffB); PG8_STAGE(PG8_SB(0, 1), b2 + hstep, voffB); PG8_STAGE(PG8_SA(0, 0), a2, voffA);
            PG8_WAIT_V(8); PG8_WAIT_L(0); PG8_BAR; PG8_MMA(1, 0, At, B0); PG8_MMA(1, 1, At, B1); PG8_BAR; PG8_SCHED;
            PG8_LDB(B0, 1, 0); PG8_LDB(B1, 1, 1); PG8_SCHED; PG8_LDA(At, 1, 0); PG8_STAGE(PG8_SA(0, 1), a2 + hstep, voffA);
            PG8_WAIT_V(8); PG8_WAIT_L(0); PG8_BAR; PG8_MMA(0, 0, At, B0); PG8_MMA(0, 1, At, B1); PG8_BAR; PG8_SCHED;
            PG8_LDA(At, 1, 1); PG8_STAGE(PG8_SB(1, 0), b3, voffB); PG8_STAGE(PG8_SB(1, 1), b3 + hstep, voffB); PG8_STAGE(PG8_SA(1, 0), a3, voffA);
            PG8_WAIT_V(8); PG8_WAIT_L(0); PG8_BAR; PG8_MMA(1, 0, At, B0); PG8_MMA(1, 1, At, B1); PG8_BAR; PG8_SCHED;
            } else {
            PG8_LDB(B0, 0, 0); PG8_SCHED; PG8_LDA(At, 0, 0); PG8_STAGE(PG8_SA(1, 1), a1 + hstep, voffA);
            PG8_WAIT_L(8); PG8_BAR; PG8_WAIT_L(0); PG8_MMA(0, 0, At, B0); PG8_BAR; PG8_SCHED;
            PG8_LDB(B1, 0, 1); PG8_STAGE(PG8_SB(0, 0), b2, voffB);
            PG8_BAR; PG8_WAIT_L(0); PG8_MMA(0, 1, At, B1); PG8_BAR;
            PG8_LDA(At, 0, 1); PG8_STAGE(PG8_SA(0, 0), a2, voffA);
            PG8_BAR; PG8_WAIT_L(0); PG8_MMA(1, 0, At, B0); PG8_BAR; PG8_SCHED;
            PG8_STAGE(PG8_SB(0, 1), b2 + hstep, voffB);
            PG8_WAIT_V(6); PG8_BAR; PG8_MMA(1, 1, At, B1); PG8_BAR;
            PG8_LDB(B0, 1, 0); PG8_SCHED; PG8_LDA(At, 1, 0); PG8_STAGE(PG8_SA(0, 1), a2 + hstep, voffA);
            PG8_WAIT_L(8); PG8_BAR; PG8_WAIT_L(0); PG8_MMA(0, 0, At, B0); PG8_BAR; PG8_SCHED;
            PG8_LDB(B1, 1, 1); PG8_STAGE(PG8_SB(1, 0), b3, voffB);
            PG8_BAR; PG8_WAIT_L(0); PG8_MMA(0, 1, At, B1); PG8_BAR;
            PG8_LDA(At, 1, 1); PG8_STAGE(PG8_SA(1, 0), a3, voffA);
            PG8_BAR; PG8_WAIT_L(0); PG8_MMA(1, 0, At, B0); PG8_BAR; PG8_SCHED;
            PG8_STAGE(PG8_SB(1, 1), b3 + hstep, voffB);
            PG8_WAIT_V(6); PG8_BAR; PG8_MMA(1, 1, At, B1); PG8_BAR;
            }
        }
        if constexpr (ALIGN_EPI) { if (wr == 0) PG8_BAR; }
        if constexpr (!Epi::AFTER_DRAIN) { E(acc, cur, wr, wc, fr, fq); S.done(cur); }
        if (!has_next) break;
#pragma unroll
        for (int a = 0; a < 2; ++a)
#pragma unroll
            for (int b = 0; b < 2; ++b)
#pragma unroll
                for (int m = 0; m < 4; ++m)
#pragma unroll
                    for (int n = 0; n < 2; ++n) acc[a][b][m][n] = (f32x4){0.f, 0.f, 0.f, 0.f};
        cur = nxt; cA = nA; cB = nB; ++ui;
        if constexpr (ALIGN_EPI) { if (wr == 1) PG8_BAR; }
    }
    PG8_WAIT_V(0);
    if constexpr (!ALIGN_EPI) { if (wr == 0) PG8_BAR; }
    PG8_BAR;
    if constexpr (Epi::AFTER_DRAIN) { E.fused(acc, cur, wr, wc, fr, fq, lds, wid, lane); S.done(cur); }
#undef PG8_SA
#undef PG8_SB
#undef PG8_STAGE
#undef PG8_LDA
#undef PG8_LDB
#undef PG8_MMA
#undef PG8_WAIT_V
#undef PG8_WAIT_L
#undef PG8_BAR
#undef PG8_SCHED
}
}
#define LAS __attribute__((address_space(3)))
typedef unsigned short bf16_t;
typedef short bf16x8 __attribute__((ext_vector_type(8)));
typedef short s16x4 __attribute__((ext_vector_type(4)));
typedef float f32x4 __attribute__((ext_vector_type(4)));
typedef float f32x16 __attribute__((ext_vector_type(16)));
typedef unsigned u32x4 __attribute__((ext_vector_type(4)));
typedef float f32x2_t __attribute__((ext_vector_type(2)));
typedef __bf16 bf16x2_t __attribute__((ext_vector_type(2)));
__device__ __forceinline__ unsigned pk2(float lo, float hi) { f32x2_t v = {lo, hi}; bf16x2_t b = __builtin_convertvector(v, bf16x2_t); return __builtin_bit_cast(unsigned, b); }
__device__ __forceinline__ float bf2f(unsigned short x) { return __uint_as_float((unsigned)x << 16); }
__device__ __forceinline__ float bflo(unsigned w) { return __uint_as_float(w << 16); }
__device__ __forceinline__ float bfhi(unsigned w) { return __uint_as_float(w & 0xffff0000u); }
__device__ __forceinline__ int crow(int r, int hi) { return (r & 3) + 8 * (r >> 2) + 4 * hi; }
__device__ __forceinline__ float wave_sum(float v) {
#pragma unroll
    for (int o = 1; o < 64; o <<= 1) v += __shfl_xor(v, o);
    return v;
}

#define GAS __attribute__((address_space(1)))
#define XB_TMO      128
#define XB_XCNT(j)  (256  + 64 * (j))
#define XB_XSUB(j)  (1280 + 64 * (j))
#define XB_XGEN(j)  (2304 + 64 * (j))
#define XB_TOP      3328
#define XB_TOPGEN   3392
#define XCD_BAR_WORDS 3456
#define XB_SPIN_CAP (1u << 18)

__device__ __forceinline__ unsigned xb_ld(unsigned* p)              { return __hip_atomic_load(p, __ATOMIC_RELAXED, __HIP_MEMORY_SCOPE_AGENT); }
__device__ __forceinline__ unsigned xb_add(unsigned* p, unsigned v) { return __hip_atomic_fetch_add(p, v, __ATOMIC_RELAXED, __HIP_MEMORY_SCOPE_AGENT); }
__device__ __forceinline__ unsigned xb_xcc_id() { return (unsigned)__builtin_amdgcn_s_getreg((3 << 11) | 20) & 0xFu; }
#define XB_SPIN(cond, bar) do { unsigned _sp = 0; while (cond) { __builtin_amdgcn_s_sleep(1); \
    if ((++_sp & 255u) == 0u) { if (xb_ld(&(bar)[XB_TMO])) break; if (_sp > XB_SPIN_CAP) { atomicAdd(&(bar)[XB_TMO], 1u); break; } } } } while (0)

struct XcdBarrier {
    unsigned* bar; unsigned x;
    volatile LAS unsigned* st;
};

__device__ __forceinline__ XcdBarrier xcd_barrier_post(unsigned* bar, volatile LAS unsigned* st) {
    XcdBarrier b; b.bar = bar; b.x = xb_xcc_id(); b.st = st;
    if (threadIdx.x == 0) (void)xb_add(&bar[XB_XCNT(b.x)], 1u);
    return b;
}
__device__ __forceinline__ void xcd_barrier_complete(unsigned* bar, unsigned x, unsigned& nloc, unsigned& nx) {
    const unsigned G = gridDim.x * gridDim.y * gridDim.z;
    unsigned sum, cnt, mine, sp = 0u;
    for (;;) {
        sum = 0u; cnt = 0u; mine = 0u;
#pragma unroll
        for (unsigned j = 0; j < 16; ++j) { const unsigned c = xb_ld(&bar[XB_XCNT(j)]); sum += c; cnt += (c > 0u) ? 1u : 0u; mine = (j == x) ? c : mine; }
        if (sum == G) break;
        __builtin_amdgcn_s_sleep(1);
        if ((++sp & 255u) == 0u) { if (xb_ld(&bar[XB_TMO])) break; if (sp > XB_SPIN_CAP) { atomicAdd(&bar[XB_TMO], 1u); break; } }
    }
    nloc = mine > 0u ? mine : 1u; nx = cnt > 0u ? cnt : 1u;
}

__device__ __forceinline__ void xcd_barrier(const XcdBarrier& b) {
    asm volatile("s_waitcnt vmcnt(0)" ::: "memory");
    __syncthreads();
    if (threadIdx.x == 0) {
        unsigned* bar = b.bar;
        __builtin_amdgcn_s_waitcnt(0);
        unsigned nloc = b.st[0], nx = b.st[1];
        if (nloc == 0u) { xcd_barrier_complete(bar, b.x, nloc, nx); b.st[0] = nloc; b.st[1] = nx; }
        const unsigned old = xb_add(&bar[XB_XSUB(b.x)], 1u);
        const unsigned gen = old / nloc;
        if (old + 1u == (gen + 1u) * nloc) {
            __builtin_amdgcn_fence(__ATOMIC_RELEASE, "agent");
            asm volatile("s_waitcnt vmcnt(0)" ::: "memory");
            const unsigned og = xb_add(&bar[XB_TOP], 1u);
            const unsigned tg = og / nx;
            if (og + 1u == (tg + 1u) * nx) xb_add(&bar[XB_TOPGEN], 1u);
            else XB_SPIN(xb_ld(&bar[XB_TOPGEN]) == tg, bar);
            __builtin_amdgcn_fence(__ATOMIC_ACQUIRE, "agent");
            xb_add(&bar[XB_XGEN(b.x)], 1u);
            asm volatile("s_waitcnt vmcnt(0)" ::: "memory");
        } else {
            XB_SPIN(xb_ld(&bar[XB_XGEN(b.x)]) == gen, bar);
            __builtin_amdgcn_fence(__ATOMIC_ACQUIRE, "agent");
            asm volatile("s_waitcnt vmcnt(0)" ::: "memory");
        }
    }
    __syncthreads();
}

struct Args { const float* in[19]; float* out; unsigned char* ws; };

__device__ __forceinline__ int perm_in0(int n) {
    if (n < 1024) { const int q8 = n >> 3, e = n & 7; return (e < 4) ? (4 * q8 + e) : (512 + 4 * q8 + (e - 4)); }
    if (n < 4096) { const int w = (n - 1024) & 63, hh = (n - 1024) >> 6, qq = w >> 3, e = w & 7; return 1024 + 64 * hh + 4 * qq + (e & 3) + ((e >= 4) ? 32 : 0); }
    return n;
}
__device__ __forceinline__ int perm_in1(int n) {
    if (n >= 512 && n < 1536) { const int mm = n - 512, q8 = mm >> 3, e = mm & 7; return (e < 4) ? (512 + 4 * q8 + e) : (1024 + 4 * q8 + (e - 4)); }
    return n;
}
struct TItem { const float* W; const float* kscale; bf16_t* WT; int K, N, perm, q; };
__device__ __forceinline__ int perm_any(int perm, int n) { return (perm == 1) ? perm_in0(n) : (perm == 2) ? perm_in1(n) : n; }
__device__ __forceinline__ void titem_load(const TItem& t, int lane, f32x4 (&v)[8]) {
    const int nblk = t.N / 32, kb = t.q / nblk, nb = t.q % nblk, k0 = 64 * kb, n0 = 32 * nb;
    const int kr = lane >> 3, n4 = lane & 7;
    const int ns = perm_any(t.perm, n0 + 4 * n4);
    const float* wp = t.W + (size_t)(k0 + kr) * t.N + ns;
#pragma unroll
    for (int i = 0; i < 8; ++i) v[i] = *(const f32x4*)(wp + (size_t)(8 * i) * t.N);
}
__device__ __forceinline__ void titem_finish(const TItem& t, int lane, const f32x4 (&v)[8], LAS float* scr) {
    const int nblk = t.N / 32, kb = t.q / nblk, nb = t.q % nblk, k0 = 64 * kb, n0 = 32 * nb;
    const int kr = lane >> 3, n4 = lane & 7;
#pragma unroll
    for (int i = 0; i < 8; ++i) { LAS float* d = scr + (kr + 8 * i) * 33 + 4 * n4; d[0] = v[i][0]; d[1] = v[i][1]; d[2] = v[i][2]; d[3] = v[i][3]; }
    asm volatile("s_waitcnt lgkmcnt(0)" ::: "memory");
    const int c = lane & 7;
    f32x4 ks0 = {1.f, 1.f, 1.f, 1.f}, ks1 = {1.f, 1.f, 1.f, 1.f};
    if (t.kscale) { ks0 = *(const f32x4*)(t.kscale + k0 + 8 * c); ks1 = *(const f32x4*)(t.kscale + k0 + 8 * c + 4); }
#pragma unroll
    for (int j = 0; j < 4; ++j) { const int n = (lane >> 3) + 8 * j; const LAS float* s = scr + (8 * c) * 33 + n;
        u32x4 o; o.x = pk2(s[0 * 33] * ks0[0], s[1 * 33] * ks0[1]); o.y = pk2(s[2 * 33] * ks0[2], s[3 * 33] * ks0[3]); o.z = pk2(s[4 * 33] * ks1[0], s[5 * 33] * ks1[1]); o.w = pk2(s[6 * 33] * ks1[2], s[7 * 33] * ks1[3]);
        *(u32x4*)(t.WT + (size_t)(n0 + n) * t.K + k0 + 8 * c) = o; }
    asm volatile("s_waitcnt lgkmcnt(0)" ::: "memory");
}

__device__ __forceinline__ s16x4 vtr(const LAS unsigned char* p) { typedef short v4i16_t __attribute__((ext_vector_type(4))); return __builtin_bit_cast(s16x4, __builtin_amdgcn_ds_read_tr16_b64_v4i16((LAS v4i16_t*)p)); }
__device__ __forceinline__ void attn_wave_unit(bf16_t* QK, const bf16_t* Vb, float* lse2, int b, int g, int h, int r, int i0, LAS unsigned char* vl, int lane) {
    const int dil = (g == 0) ? 1 : (g == 1 ? 4 : 16);
    const int hh = g * 8 + h, ql = lane & 31, hi = lane >> 5;
    const size_t rowbase = (size_t)b * SEQ + r;
    const bf16_t* qp = QK + (rowbase + (size_t)(i0 + ql) * dil) * 3072 + hh * 64 + hi * 8;
    bf16x8 qf[4];
#pragma unroll
    for (int s = 0; s < 4; ++s) qf[s] = *(const bf16x8*)(qp + 16 * s);
    bf16x8 kf[5][4];
#pragma unroll
    for (int j = 0; j < 5; ++j) {
        int kr = i0 - 128 + 32 * j + ql; kr = kr < 0 ? 0 : kr;
        const bf16_t* kp = QK + (rowbase + (size_t)kr * dil) * 3072 + 1536 + hh * 64 + hi * 8;
#pragma unroll
        for (int s = 0; s < 4; ++s) kf[j][s] = *(const bf16x8*)(kp + 16 * s);
    }
    u32x4 vr[5][4];
#pragma unroll
    for (int j = 0; j < 5; ++j)
#pragma unroll
        for (int i = 0; i < 4; ++i) { int rk = i0 - 128 + 32 * j + 8 * i + (lane >> 3); rk = rk < 0 ? 0 : rk;
            vr[j][i] = *(const u32x4*)(Vb + (rowbase + (size_t)rk * dil) * 1536 + hh * 64 + (lane & 7) * 8); }
    f32x16 S[5];
    const float NEG = -INFINITY;
#pragma unroll
    for (int j = 0; j < 5; ++j) {
        const bool tv = (i0 - 128 + 32 * j) >= 0;
        f32x16 acc = {};
#pragma unroll
        for (int s = 0; s < 4; ++s) acc = __builtin_amdgcn_mfma_f32_32x32x16_bf16(kf[j][s], qf[s], acc, 0, 0, 0);
#pragma unroll
        for (int rr = 0; rr < 16; ++rr) {
            bool ok = tv;
            if (j == 0) ok = ok && (crow(rr, hi) >= ql);
            if (j == 4) ok = ok && (crow(rr, hi) <= ql);
            acc[rr] = ok ? acc[rr] : NEG;
        }
        S[j] = acc;
    }
    float mx = NEG;
#pragma unroll
    for (int j = 0; j < 5; ++j)
#pragma unroll
        for (int rr = 0; rr < 16; ++rr) mx = fmaxf(mx, S[j][rr]);
    mx = fmaxf(mx, __shfl_xor(mx, 32));
    float l = 0.f;
#pragma unroll
    for (int j = 0; j < 5; ++j)
#pragma unroll
        for (int rr = 0; rr < 16; ++rr) { const float pe = __builtin_amdgcn_exp2f(S[j][rr] - mx); S[j][rr] = pe; l += pe; }
    l += __shfl_xor(l, 32);
    const float inv = 1.f / l;
    if (hi == 0) lse2[((size_t)g * M + rowbase + (size_t)(i0 + ql) * dil) * 8 + h] = mx + __builtin_amdgcn_logf(l);
    f32x16 O0 = {}, O1 = {};
    const int li = lane & 15, gq = li >> 2, gp = li & 3, chh = (lane >> 4) & 1;
#pragma unroll
    for (int j = 0; j < 5; ++j) {
        LAS unsigned char* vb_ = vl + (j & 1) * 4096;
#pragma unroll
        for (int i = 0; i < 4; ++i) *(LAS u32x4*)(vb_ + (8 * i + (lane >> 3)) * 128 + (lane & 7) * 16) = vr[j][i];
        asm volatile("s_waitcnt lgkmcnt(0)" ::: "memory");
#pragma unroll
        for (int s = 0; s < 2; ++s) {
            u32x4 pw;
            pw.x = pk2(S[j][8 * s + 0] * inv, S[j][8 * s + 1] * inv); pw.y = pk2(S[j][8 * s + 2] * inv, S[j][8 * s + 3] * inv);
            pw.z = pk2(S[j][8 * s + 4] * inv, S[j][8 * s + 5] * inv); pw.w = pk2(S[j][8 * s + 6] * inv, S[j][8 * s + 7] * inv);
            const bf16x8 pa = __builtin_bit_cast(bf16x8, pw);
#pragma unroll
            for (int db = 0; db < 2; ++db) {
                const LAS unsigned char* a1 = vb_ + (16 * s + 4 * hi + gq) * 128 + (32 * db + 16 * chh + 4 * gp) * 2;
                const s16x4 lo = vtr(a1), hv = vtr(a1 + 8 * 128);
                const bf16x8 vb = {lo[0], lo[1], lo[2], lo[3], hv[0], hv[1], hv[2], hv[3]};
                if (db == 0) O0 = __builtin_amdgcn_mfma_f32_32x32x16_bf16(pa, vb, O0, 0, 0, 0);
                else O1 = __builtin_amdgcn_mfma_f32_32x32x16_bf16(pa, vb, O1, 0, 0, 0);
            }
        }
    }
    asm volatile("s_waitcnt lgkmcnt(0)" ::: "memory");
#pragma unroll
    for (int rr = 0; rr < 16; ++rr) { const int q = crow(rr, hi);
        *(LAS bf16_t*)(vl + q * 128 + ql * 2) = (bf16_t)(pk2(O0[rr], 0.f) & 0xffffu);
        *(LAS bf16_t*)(vl + q * 128 + (32 + ql) * 2) = (bf16_t)(pk2(O1[rr], 0.f) & 0xffffu); }
    asm volatile("s_waitcnt lgkmcnt(0)" ::: "memory");
#pragma unroll
    for (int i = 0; i < 4; ++i) { const int rq = 8 * i + (lane >> 3), ch = lane & 7;
        const u32x4 v = *(const LAS u32x4*)(vl + rq * 128 + ch * 16);
        *(u32x4*)(QK + (rowbase + (size_t)(i0 + rq) * dil) * 3072 + hh * 64 + ch * 8) = v; }
    asm volatile("s_waitcnt lgkmcnt(0)" ::: "memory");
}

__device__ __forceinline__ float transpose_reduce32(float (&a)[32], int lane) {
#pragma unroll
    for (int n = 16; n >= 1; n >>= 1) {
        const bool bit = (lane & n) != 0;
#pragma unroll
        for (int i = 0; i < n; ++i) { const float lo = a[i], hv = a[i + n]; const float send = bit ? lo : hv, keep = bit ? hv : lo; a[i] = keep + __shfl_xor(send, n); }
    }
    return a[0] + __shfl_xor(a[0], 32);
}

__global__ void __launch_bounds__(512, 2) mk_fwd(Args args) {
    extern __shared__ __attribute__((aligned(16))) unsigned char lds_raw[];
    LAS unsigned char* lds = (LAS unsigned char*)lds_raw;
    const int tid = threadIdx.x, lane = tid & 63, wave = __builtin_amdgcn_readfirstlane(tid >> 6);
    const int G = gridDim.x, bx = blockIdx.x;
    const int vcu = (G % 8 == 0) ? (bx % 8) * (G / 8) + bx / 8 : bx;
    const int gw = vcu * 8 + wave, NGW = G * 8;
    const int gtid = bx * 512 + tid, NT = G * 512;
    unsigned char* ws = args.ws;
#if defined(PROBE_LO)
#define TSB ((unsigned long long*)(args.ws + 65536))
#define STAMP(k) do { if (blockIdx.x == 0 && threadIdx.x == 0) TSB[k] = __builtin_amdgcn_s_memrealtime(); } while (0)
    STAMP(0);
#else
#define STAMP(k) do {} while (0)
#endif
    for (int u = tid; u < (LDS_BYTES - 131072) / 4; u += 512) ((LAS unsigned*)(lds + 131072))[u] = 0u;
    __syncthreads();
    volatile LAS unsigned* MISC = (volatile LAS unsigned*)(lds + 131072 + 320);
    unsigned* ctl = (unsigned*)(ws + WS_CTL);
    const XcdBarrier bar = xcd_barrier_post(ctl, MISC + 8);
    const float* x = args.in[0];
    float* out = args.out;
    float* cs = (float*)(ws + WS_CS);
    float* ss = (float*)(ws + WS_SS);
    float* vst = (float*)(ws + WS_VST);
    float* lse2 = (float*)(ws + WS_LSE);
    bf16_t* Win0 = (bf16_t*)(ws + WS_WIN0); bf16_t* Wout0 = (bf16_t*)(ws + WS_WOUT0); bf16_t* W1_0 = (bf16_t*)(ws + WS_W1_0); bf16_t* W2_0 = (bf16_t*)(ws + WS_W2_0);
    bf16_t* Win1 = (bf16_t*)(ws + WS_WIN1); bf16_t* Wout1 = (bf16_t*)(ws + WS_WOUT1); bf16_t* W1_1 = (bf16_t*)(ws + WS_W1_1); bf16_t* W2_1 = (bf16_t*)(ws + WS_W2_1);
    bf16_t* R1 = (bf16_t*)(ws + WS_R1); bf16_t* GLU = (bf16_t*)(ws + WS_GLU); bf16_t* H1B = (bf16_t*)(ws + WS_H1B);
    bf16_t* QK = (bf16_t*)(ws + WS_QK); bf16_t* VB = (bf16_t*)(ws + WS_V); bf16_t* U = (bf16_t*)(ws + WS_U);
    bf16_t* GB = (bf16_t*)(ws + WS_GB); bf16_t* GG = (bf16_t*)(ws + WS_G); bf16_t* UB = (bf16_t*)(ws + WS_UB); bf16_t* VT = (bf16_t*)(ws + WS_VT); bf16_t* MIX1 = (bf16_t*)(ws + WS_MIX1);

    {
        for (int i = gtid; i < 4 * M + 2 * M; i += NT) { if (i < 4 * M) ss[M + i] = 0.f; else vst[i - 4 * M] = 0.f; }
        for (int i = gtid; i < SEQ * 32; i += NT) { const int s = i >> 5, f = i & 31; const float inv = powf(10000.0f, -(float)f / 32.0f); const float ang = (float)s * inv; float sn, c; sincosf(ang, &sn, &c); cs[2 * i] = c; cs[2 * i + 1] = sn; }
        { float* ckT = (float*)(ws + WS_CKT); const float* ck_ = args.in[4]; for (int i = gtid; i < 512 * 32; i += NT) { const int c_ = i >> 5, j_ = i & 31; ckT[i] = (j_ < 31) ? ck_[j_ * 512 + c_] : 0.f; } }
        LAS float* scr = (LAS float*)(lds + wave * 16384);
        constexpr int I_IN0 = 16 * (NIN0 / 32), I_OUT = 16 * 32, I_W1 = 16 * (FF / 32), I_W2 = 64 * 32, I_IN1 = 16 * (NIN1 / 32);
        constexpr int NITEMS = I_IN0 + I_OUT + I_W1 + I_W2 + I_IN1 + I_OUT + I_W1 + I_W2;
        auto decode = [&](int it) -> TItem {
            int q = it;
            if (q < I_IN0) return TItem{args.in[3], args.in[1], Win0, 1024, NIN0, 1, q}; q -= I_IN0;
            if (q < I_OUT) return TItem{args.in[8], nullptr, Wout0, 1024, 1024, 0, q}; q -= I_OUT;
            if (q < I_W1) return TItem{args.in[16], args.in[2], W1_0, 1024, FF, 0, q}; q -= I_W1;
            if (q < I_W2) return TItem{args.in[17], nullptr, W2_0, FF, 1024, 0, q}; q -= I_W2;
            if (q < I_IN1) return TItem{args.in[9], args.in[1] + 1024, Win1, 1024, NIN1, 2, q}; q -= I_IN1;
            if (q < I_OUT) return TItem{args.in[15], nullptr, Wout1, 1024, 1024, 0, q}; q -= I_OUT;
            if (q < I_W1) return TItem{args.in[16] + (size_t)1024 * FF, args.in[2] + 1024, W1_1, 1024, FF, 0, q}; q -= I_W1;
            return TItem{args.in[17] + (size_t)FF * 1024, nullptr, W2_1, FF, 1024, 0, q};
        };
        {
            int it = gw; f32x4 va[8], vb[8]; TItem ta{}, tb{};
            if (it < NITEMS) { ta = decode(it); titem_load(ta, lane, va); }
            while (it < NITEMS) {
                const int nx = it + NGW;
                if (nx < NITEMS) { tb = decode(nx); titem_load(tb, lane, vb); }
                titem_finish(ta, lane, va, scr);
                ta = tb;
#pragma unroll
                for (int i = 0; i < 8; ++i) va[i] = vb[i];
                it = nx;
            }
        }
        for (int row0 = gw * 4; row0 < M; row0 += NGW * 4) {
            f32x4 v[4][4];
#pragma unroll
            for (int rr = 0; rr < 4; ++rr)
#pragma unroll
                for (int j = 0; j < 4; ++j) v[rr][j] = ((const f32x4*)(x + (size_t)(row0 + rr) * 1024) + lane)[64 * j];
#pragma unroll
            for (int rr = 0; rr < 4; ++rr) { float sq = 0.f; unsigned long long* o8 = (unsigned long long*)(R1 + (size_t)(row0 + rr) * 1024) + lane;
#pragma unroll
                for (int j = 0; j < 4; ++j) { const f32x4 w = v[rr][j]; sq += (w[0] * w[0] + w[1] * w[1]) + (w[2] * w[2] + w[3] * w[3]); o8[64 * j] = (unsigned long long)pk2(w[0], w[1]) | ((unsigned long long)pk2(w[2], w[3]) << 32); }
                sq = wave_sum(sq); if (lane == 0) ss[row0 + rr] = sq; }
        }
    }
    xcd_barrier(bar);
    STAMP(1);
    {
        pg8::Gemm g{R1, Win0, M, NIN0, 1024}; pg8::StaticOrder S; S.init(M, NIN0, G, bx);
        pg8::EpiP p{}; p.ss = ss; p.o0 = GLU; p.o1 = QK; p.o2 = VB; p.cs = cs;
        pg8::Epi<0> E{p};
        pg8::gemm_phase<pg8::Epi<0>, pg8::StaticOrder, true, true>(lds, g, S, E);
    }
    xcd_barrier(bar);
    STAMP(2);
    {
#ifndef NO_ATTN
        for (int unit = vcu; unit < 256; unit += G) {
            const int b = unit >> 5, h = (unit >> 2) & 7, tb = unit & 3;
            LAS unsigned char* vl = lds + wave * 8192;
#pragma unroll 1
            for (int k = 0; k < 6; ++k) {
                const int wu = __builtin_amdgcn_readfirstlane(k * 8 + wave);
                const int g = wu >> 4, e = wu & 15;
                int r, i0;
                if (g == 0) { r = 0; i0 = tb * 512 + 32 * e; }
                else if (g == 1) { r = e & 3; i0 = tb * 128 + 32 * (e >> 2); }
                else { r = e; i0 = tb * 32; }
                attn_wave_unit(QK, VB, lse2, b, g, h, r, i0, vl, lane);
            }
            asm volatile("s_waitcnt vmcnt(0)" ::: "memory");
            __syncthreads();
            STAMP(20);
#pragma unroll 2
            for (int it = 0; it < 8; ++it) {
                const int tl = it * 64 + (tid >> 3), ch = tid & 7; const size_t row = (size_t)b * SEQ + tb * 512 + tl;
                const float l0 = lse2[((size_t)0 * M + row) * 8 + h], l1 = lse2[((size_t)1 * M + row) * 8 + h], l2 = lse2[((size_t)2 * M + row) * 8 + h];
                const float mxl = fmaxf(l0, fmaxf(l1, l2));
                float e0 = __builtin_amdgcn_exp2f(l0 - mxl), e1 = __builtin_amdgcn_exp2f(l1 - mxl), e2 = __builtin_amdgcn_exp2f(l2 - mxl);
                const float inv = 1.f / (e0 + e1 + e2); e0 *= inv; e1 *= inv; e2 *= inv;
                const u32x4 a0 = *(const u32x4*)(QK + row * 3072 + (0 + h) * 64 + ch * 8), a1 = *(const u32x4*)(QK + row * 3072 + (8 + h) * 64 + ch * 8), a2 = *(const u32x4*)(QK + row * 3072 + (16 + h) * 64 + ch * 8);
                u32x4 o;
#pragma unroll
                for (int w = 0; w < 4; ++w) o[w] = pk2(e0 * bflo(a0[w]) + e1 * bflo(a1[w]) + e2 * bflo(a2[w]), e0 * bfhi(a0[w]) + e1 * bfhi(a1[w]) + e2 * bfhi(a2[w]));
                *(u32x4*)(R1 + row * 1024 + 512 + h * 64 + ch * 8) = o;
            }
            __syncthreads();
        }
    STAMP(21);
#endif
#ifndef NO_CONV
        const float* cb = args.in[5]; const float* lg = args.in[6]; const float* lb = args.in[7];
        LAS float* part = (LAS float*)(lds + 65536); LAS float* stat = (LAS float*)(lds + 65536 + 4096);
        for (int tile = vcu; tile < 512; tile += G) {
            int tidc = threadIdx.x; asm volatile("" : "+v"(tidc));
            const int t0 = tile * 32, tseq = t0 & 2047;
            {
                const int ch = tidc & 63, r0 = tidc >> 6;
                const bf16_t* gp = GLU + (size_t)(t0 - 30 + r0) * 512 + ch * 8;
                LAS unsigned char* lp = lds + r0 * 1024 + ch * 16;
#pragma unroll
                for (int it = 0; it < 8; ++it) { const int rr = r0 + 8 * it;
                    if (rr < 62) { u32x4 v = {0u, 0u, 0u, 0u}; if (tseq - 30 + rr >= 0) v = *(const u32x4*)(gp + (size_t)it * 8 * 512); *(LAS u32x4*)(lp + it * 8192) = v; } }
            }
            __syncthreads();
            const int c = tidc;
            float o[32];
            {
                float kk[32];
                { const f32x4* kp4 = (const f32x4*)((const float*)(ws + WS_CKT) + c * 32);
#pragma unroll
                  for (int j4 = 0; j4 < 8; ++j4) { const f32x4 kq = kp4[j4]; kk[4 * j4] = kq[0]; kk[4 * j4 + 1] = kq[1]; kk[4 * j4 + 2] = kq[2]; kk[4 * j4 + 3] = kq[3]; } }
                const float bias = cb[c];
                float xv[62];
#pragma unroll
                for (int i = 0; i < 46; ++i) xv[i] = bf2f(*(const LAS bf16_t*)(lds + i * 1024 + c * 2));
#pragma unroll
                for (int t = 0; t < 16; ++t) { float acc = bias;
#pragma unroll
                    for (int j = 0; j < 31; ++j) acc += kk[j] * xv[t + j];
                    o[t] = acc; }
                asm volatile("" ::: "memory");
#pragma unroll
                for (int i = 46; i < 62; ++i) xv[i] = bf2f(*(const LAS bf16_t*)(lds + i * 1024 + c * 2));
#pragma unroll
                for (int t = 16; t < 32; ++t) { float acc = bias;
#pragma unroll
                    for (int j = 0; j < 31; ++j) acc += kk[j] * xv[t + j];
                    o[t] = acc; }
            }
            {
                float a[32];
#pragma unroll
                for (int t = 0; t < 32; ++t) a[t] = o[t];
                const float s1 = transpose_reduce32(a, lane);
#pragma unroll
                for (int t = 0; t < 32; ++t) a[t] = o[t] * o[t];
                const float s2 = transpose_reduce32(a, lane);
                if (lane < 32) { part[(lane * 8 + wave) * 2] = s1; part[(lane * 8 + wave) * 2 + 1] = s2; }
            }
            __syncthreads();
            if (tidc < 32) { float s1 = 0.f, s2 = 0.f;
#pragma unroll
                for (int w = 0; w < 8; ++w) { s1 += part[(tidc * 8 + w) * 2]; s2 += part[(tidc * 8 + w) * 2 + 1]; }
                const float mean = s1 * (1.f / 512.f), var = s2 * (1.f / 512.f) - mean * mean;
                stat[2 * tidc] = mean; stat[2 * tidc + 1] = rsqrtf(fmaxf(var, 0.f) + EPS); }
            __syncthreads();
            const float lgc = lg[c], lbc = lb[c];
#pragma unroll
            for (int t = 0; t < 32; ++t) { const float mean = stat[2 * t], rstd = stat[2 * t + 1]; const float y = (o[t] - mean) * rstd * lgc + lbc; const float a = y * pg8::sigm(y);
                *(LAS bf16_t*)(lds + t * 1024 + c * 2) = (bf16_t)(pk2(a, 0.f) & 0xffffu); }
            __syncthreads();
            for (int idx = tidc; idx < 32 * 64; idx += 512) { const int rr = idx >> 6, ch = idx & 63; const u32x4 v = *(const LAS u32x4*)(lds + rr * 1024 + ch * 16); *(u32x4*)(R1 + (size_t)(t0 + rr) * 1024 + ch * 8) = v; }
            __syncthreads();
        }
#endif
    }
    xcd_barrier(bar);
    STAMP(3);
    {
        pg8::Gemm g{R1, Wout0, M, 1024, 1024}; pg8::StaticOrder S; S.init(M, 1024, G, bx);
        pg8::EpiP p{}; p.resid = x; p.o0 = H1B; p.ss_out = ss + M;
        pg8::Epi<1> E{p};
        pg8::gemm_phase<pg8::Epi<1>, pg8::StaticOrder, true, true>(lds, g, S, E);
    }
    xcd_barrier(bar);
    STAMP(4);
    {
        pg8::Gemm g{H1B, W1_0, M, FF, 1024}; pg8::StaticOrder S; S.init(M, FF, G, bx);
        pg8::EpiP p{}; p.ss = ss + M; p.o0 = U;
        pg8::Epi<2> E{p};
        pg8::gemm_phase<pg8::Epi<2>, pg8::StaticOrder, true, true>(lds, g, S, E);
    }
    xcd_barrier(bar);
    STAMP(5);
    {
        pg8::Gemm g{U, W2_0, M, 1024, FF}; pg8::StaticOrder S; S.init(M, 1024, G, bx);
        pg8::EpiP p{}; p.hb = H1B; p.o0 = R1; p.ss_out = ss + 2 * M;
        pg8::Epi<4> E{p};
        pg8::gemm_phase<pg8::Epi<4>, pg8::StaticOrder, true, true>(lds, g, S, E);
    }
    xcd_barrier(bar);
    STAMP(6);
    {
        pg8::Gemm g{R1, Win1, M, NIN1, 1024}; pg8::StaticOrder S; S.init(M, NIN1, G, bx);
        pg8::EpiP p{}; p.ss = ss + 2 * M; p.o0 = GB; p.o1 = GG; p.o2 = UB; p.o3 = VT; p.vst = vst;
        pg8::Epi<3> E{p};
        pg8::gemm_phase<pg8::Epi<3>, pg8::StaticOrder, true, true>(lds, g, S, E);
    }
    xcd_barrier(bar);
    STAMP(7);
    {
        const float* sk = args.in[10]; const float* lg = args.in[11]; const float* lb = args.in[12]; const float* sgw = args.in[13]; const float* sgb = args.in[14];
        for (int idx = gtid; idx < M * 64; idx += NT) {
            const int row = idx >> 6, ch = idx & 63, tseq = row & 2047;
            const u32x4 gbv = *(const u32x4*)(GB + (size_t)row * 512 + ch * 8);
            float acc[8];
#pragma unroll
            for (int e = 0; e < 8; ++e) acc[e] = 0.f;
#pragma unroll
            for (int j = 0; j < 3; ++j) {
                if (tseq - 2 + j >= 0) {
                    const u32x4 gv = *(const u32x4*)(GG + (size_t)(row - 2 + j) * 512 + ch * 8);
                    const f32x4 k0 = *(const f32x4*)(sk + j * 512 + ch * 8), k1 = *(const f32x4*)(sk + j * 512 + ch * 8 + 4);
                    acc[0] += k0[0] * bflo(gv[0]); acc[1] += k0[1] * bfhi(gv[0]); acc[2] += k0[2] * bflo(gv[1]); acc[3] += k0[3] * bfhi(gv[1]);
                    acc[4] += k1[0] * bflo(gv[2]); acc[5] += k1[1] * bfhi(gv[2]); acc[6] += k1[2] * bflo(gv[3]); acc[7] += k1[3] * bfhi(gv[3]);
                }
            }
            u32x4 o;
#pragma unroll
            for (int w = 0; w < 4; ++w) o[w] = pk2(bflo(gbv[w]) * acc[2 * w], bfhi(gbv[w]) * acc[2 * w + 1]);
            *(u32x4*)(MIX1 + (size_t)row * 1024 + ch * 8) = o;
        }
#ifndef NO_SGU
        LAS float* RS = (LAS float*)lds; LAS float* MU = RS + 128; LAS float* RHO = RS + 256; LAS float* SIG = RS + 384;
        const int ql = lane & 31, hi = lane >> 5;
        for (int unit = vcu; unit < 512; unit += G) {
            const int n = unit >> 2, gi = unit & 3, tok0 = n * 128;
            if (tid < 128) { const float sm = vst[2 * (tok0 + tid)], sq = vst[2 * (tok0 + tid) + 1]; const float mean = sm * (1.f / 512.f), var = sq * (1.f / 512.f) - mean * mean;
                RS[tid] = rsqrtf(fmaxf(var, 0.f) + EPS); MU[tid] = mean; }
            __syncthreads();
            if (tid < 128) { const float* wr_ = sgw + ((size_t)gi * 128 + tid) * 128; float sg = 0.f, rho = 0.f;
                for (int s = 0; s <= tid; ++s) { const float w = wr_[s]; sg += w; rho += w * RS[s] * MU[s]; }
                RHO[tid] = rho; SIG[tid] = sg; }
            const int tr = wave >> 1, tc0 = (wave & 1) * 2;
            f32x16 D0 = {}, D1 = {};
            const int t = 32 * tr + ql;
            const float* wp = sgw + ((size_t)gi * 128 + t) * 128 + 8 * hi;
            const bf16_t* vp0 = VT + ((size_t)gi * 128 + 32 * tc0 + ql) * M + tok0 + 8 * hi;
            const bf16_t* vp1 = vp0 + (size_t)32 * M;
            for (int s0 = 0; s0 < 32 * (tr + 1); s0 += 16) {
                const f32x4 w0 = *(const f32x4*)(wp + s0), w1 = *(const f32x4*)(wp + s0 + 4);
                float av[8];
#pragma unroll
                for (int j = 0; j < 4; ++j) { av[j] = w0[j]; av[j + 4] = w1[j]; }
#pragma unroll
                for (int j = 0; j < 8; ++j) { const int s = s0 + 8 * hi + j; av[j] = (s <= t) ? av[j] * RS[s] : 0.f; }
                u32x4 aw; aw.x = pk2(av[0], av[1]); aw.y = pk2(av[2], av[3]); aw.z = pk2(av[4], av[5]); aw.w = pk2(av[6], av[7]);
                const bf16x8 af = __builtin_bit_cast(bf16x8, aw);
                const bf16x8 b0 = *(const bf16x8*)(vp0 + s0), b1 = *(const bf16x8*)(vp1 + s0);
                D0 = __builtin_amdgcn_mfma_f32_32x32x16_bf16(af, b0, D0, 0, 0, 0);
                D1 = __builtin_amdgcn_mfma_f32_32x32x16_bf16(af, b1, D1, 0, 0, 0);
            }
            __syncthreads();
#pragma unroll
            for (int q = 0; q < 2; ++q) {
                const int chn = gi * 128 + 32 * (tc0 + q) + ql; const float lgc = lg[chn], lbc = lb[chn];
#pragma unroll
                for (int rr = 0; rr < 16; ++rr) { const int tt = 32 * tr + crow(rr, hi); const size_t token = (size_t)tok0 + tt;
                    const float dv = (q == 0) ? D0[rr] : D1[rr];
                    const float val = lgc * (dv - RHO[tt]) + lbc * SIG[tt] + sgb[gi * 128 + tt];
                    const float uu = bf2f(UB[token * 512 + chn]);
                    MIX1[token * 1024 + 512 + chn] = (bf16_t)(pk2(uu * val, 0.f) & 0xffffu); }
            }
            __syncthreads();
        }
#endif
    }
    xcd_barrier(bar);
    STAMP(8);
    {
        pg8::Gemm g{MIX1, Wout1, M, 1024, 1024}; pg8::StaticOrder S; S.init(M, 1024, G, bx);
        pg8::EpiP p{}; p.hb = R1; p.o0 = R1; p.ss_out = ss + 3 * M;
        pg8::Epi<4> E{p};
        pg8::gemm_phase<pg8::Epi<4>, pg8::StaticOrder, true, true>(lds, g, S, E);
    }
    xcd_barrier(bar);
    STAMP(9);
    {
        pg8::Gemm g{R1, W1_1, M, FF, 1024}; pg8::StaticOrder S; S.init(M, FF, G, bx);
        pg8::EpiP p{}; p.ss = ss + 3 * M; p.o0 = U;
        pg8::Epi<2> E{p};
        pg8::gemm_phase<pg8::Epi<2>, pg8::StaticOrder, true, true>(lds, g, S, E);
    }
    xcd_barrier(bar);
    STAMP(10);
    {
        pg8::Gemm g{U, W2_1, M, 1024, FF}; pg8::StaticOrder S; S.init(M, 1024, G, bx);
        pg8::EpiP p{}; p.hb = R1; p.o0 = R1; p.ss_out = ss + 4 * M;
        pg8::Epi<4> E{p};
        pg8::gemm_phase<pg8::Epi<4>, pg8::StaticOrder, true, true>(lds, g, S, E);
    }
    xcd_barrier(bar);
    STAMP(11);
    {
        const float* fg = args.in[18];
        for (int row = gw; row < M; row += NGW) {
            const float r = rsqrtf(ss[4 * M + row] * (1.f / 1024.f) + EPS);
            f32x4* orow = (f32x4*)(out + (size_t)row * 1024) + lane; const f32x4* gr = (const f32x4*)fg + lane;
            const unsigned long long* hrow = (const unsigned long long*)(R1 + (size_t)row * 1024) + lane;
#pragma unroll
            for (int j = 0; j < 4; ++j) { const unsigned long long w = hrow[64 * j]; const unsigned lo = (unsigned)w, hv = (unsigned)(w >> 32);
                const f32x4 v = {bflo(lo), bfhi(lo), bflo(hv), bfhi(hv)}; orow[64 * j] = v * r * gr[64 * j]; }
        }
    }
#if defined(PROBE_LO)
    xcd_barrier(bar);
    STAMP(12);
    xcd_barrier(bar);
    {
        const float XA = (float)(TSB[PROBE_HI] - TSB[PROBE_LO]) * 0.01f, YB = 0.f;
        float* o_ = args.out; const int g_ = blockIdx.x * 512 + threadIdx.x, n_ = gridDim.x * 512;
        (void)n_; (void)YB;
        if (g_ == 0) o_[0] = XA;
    }
#endif
}

extern "C" void kernel_launch(void* const* d_in, const int* in_sizes, int n_in, void* d_out, int out_size, void* d_ws, size_t ws_size, hipStream_t stream) {
    static int grid = 0;
    if (grid == 0) {
        if (n_in != 19 || out_size != M * DM || ws_size < WS_END) { fprintf(stderr, "kernel_launch: unexpected shapes (n_in %d out %d ws %zu)\n", n_in, out_size, ws_size); grid = -1; return; }
        int dev = 0, cus = 0, per_cu = 0;
        hipGetDevice(&dev); hipDeviceGetAttribute(&cus, hipDeviceAttributeMultiprocessorCount, dev);
        if (hipFuncSetAttribute((const void*)mk_fwd, hipFuncAttributeMaxDynamicSharedMemorySize, LDS_BYTES) != hipSuccess) { fprintf(stderr, "kernel_launch: hipFuncSetAttribute failed\n"); grid = -1; return; }
        if (hipOccupancyMaxActiveBlocksPerMultiprocessor(&per_cu, (const void*)mk_fwd, 512, LDS_BYTES) != hipSuccess || per_cu < 1) { fprintf(stderr, "kernel_launch: occupancy query says %d\n", per_cu); per_cu = 1; }
        (void)hipGetLastError();
        grid = cus;
        fprintf(stderr, "kernel_launch: cus %d per_cu %d grid %d\n", cus, per_cu, grid);
    }
    if (grid < 0) return;
    Args a{};
    for (int i = 0; i < 19; ++i) a.in[i] = (const float*)d_in[i];
    a.out = (float*)d_out; a.ws = (unsigned char*)d_ws;
    if (hipMemsetAsync((char*)d_ws + WS_CTL, 0, 16384, stream) != hipSuccess) { fprintf(stderr, "kernel_launch: memset failed\n"); return; }
    hipLaunchKernelGGL(mk_fwd, dim3(grid), dim3(512), LDS_BYTES, stream, a);
    hipError_t e = hipPeekAtLastError();
    if (e != hipSuccess) fprintf(stderr, "launch failed: %s (grid %d)\n", hipGetErrorString(e), grid);
}
```

```cpp
#include <hip/hip_runtime.h>
#include <hip/hip_cooperative_groups.h>
#include <cstdio>
#include <cstdint>
namespace cg = cooperative_groups;

#ifndef MK_CHECK
#define MK_CHECK 0
#endif

constexpr int M = 16384, DM = 1024, SEQ = 2048, NIN0 = 5632, NIN1 = 2560, FF = 4096;
constexpr float EPS = 1e-6f;
constexpr float QSCALE = 0.125f * 1.4426950408889634f;
constexpr size_t MiB = 1u << 20;
constexpr size_t WS_CTL = 0;
constexpr size_t WS_CS = 1 * MiB;
constexpr size_t WS_SS = WS_CS + 512 * 1024;
constexpr size_t WS_VST = WS_SS + 5 * M * 4;
constexpr size_t WS_CKT = WS_VST + 2 * M * 4;
constexpr size_t WS_LSE = 2 * MiB;
constexpr size_t WS_W = 4 * MiB;
constexpr size_t WS_WIN0 = WS_W, WS_WOUT0 = WS_WIN0 + 11 * MiB, WS_W1_0 = WS_WOUT0 + 2 * MiB, WS_W2_0 = WS_W1_0 + 8 * MiB;
constexpr size_t WS_WIN1 = WS_W2_0 + 8 * MiB, WS_WOUT1 = WS_WIN1 + 5 * MiB, WS_W1_1 = WS_WOUT1 + 2 * MiB, WS_W2_1 = WS_W1_1 + 8 * MiB;
constexpr size_t WS_R1 = 56 * MiB;
constexpr size_t WS_GLU = 88 * MiB;
constexpr size_t WS_H1B = 88 * MiB;
constexpr size_t WS_QK = 104 * MiB;
constexpr size_t WS_V = 200 * MiB;
constexpr size_t WS_U = 120 * MiB;
constexpr size_t WS_GB = 88 * MiB, WS_G = 104 * MiB, WS_UB = 120 * MiB, WS_VT = 136 * MiB, WS_MIX1 = 152 * MiB;
constexpr size_t WS_END = 248 * MiB;
static_assert(WS_W2_1 + 8 * MiB == WS_R1, "weights end at R1");
constexpr int LDS_BYTES = 147456;

namespace pg8 {
#define PG8_LAS __attribute__((address_space(3)))
typedef unsigned short bf16_t;
typedef short bf16x8 __attribute__((ext_vector_type(8)));
typedef float f32x4 __attribute__((ext_vector_type(4)));
typedef unsigned u32x4 __attribute__((ext_vector_type(4)));
constexpr int BM = 256, BK = 64, HALF = 128, HTB = HALF * BK * 2  , STAGE_BYTES = 8 * HTB, NXCD = 8, WGM = 8;

__host__ __device__ __forceinline__ int lds_byte(int r, int c) { const int st = (r >> 4) * 2 + (c >> 5), rr = r & 15, cc = c & 31, ob = rr * 64 + cc * 2; return st * 1024 + (ob ^ (((ob >> 9) & 1) << 5)); }
__host__ __device__ __forceinline__ void stage_rc(int b, int& R, int& C) { const int st = b / 1024, sb = b % 1024, swz = sb ^ (((sb >> 9) & 1) << 5); R = (st >> 1) * 16 + swz / 64; C = (st & 1) * 32 + (swz % 64) / 2; }
__host__ __device__ __forceinline__ int perm32(int rho) { const int n = rho >> 4, i = rho & 15; return 8 * (i >> 2) + 4 * n + (i & 3); }

struct Unit { int pm, pn; };
struct Gemm { const bf16_t* A; const bf16_t* Bt; int M, N, K; };

struct StaticOrder {
    int nM, nN, nwg, G, c;
    __host__ __device__ void init(int M, int N, int G_, int c_) { nM = M / BM; nN = N / BM; nwg = nM * nN; G = G_; c = c_; }
    __host__ __device__ bool next(int i, Unit& u) const {
        const long L = (long)i * G + c; if (L >= nwg) return false;
        int wgid = (int)L; { const int q = nwg / NXCD, r = nwg % NXCD, xcd = wgid % NXCD, off = wgid / NXCD; wgid = (xcd < r ? xcd * (q + 1) : r * (q + 1) + (xcd - r) * q) + off; }
        const int nig = WGM * nN, gid = wgid / nig, fm = gid * WGM, gsz = (nM - fm) < WGM ? (nM - fm) : WGM;
        u.pm = fm + ((wgid % nig) % gsz); u.pn = (wgid % nig) / gsz; return true;
    }
    __device__ __forceinline__ void a_ready(const Unit&) const {}
    __device__ __forceinline__ void done(const Unit&) const {}
};

__device__ __forceinline__ unsigned cvt_pk_bf16(float lo, float hi) { unsigned r; asm volatile("v_cvt_pk_bf16_f32 %0, %1, %2" : "=v"(r) : "v"(lo), "v"(hi)); return r; }
typedef float f32x2 __attribute__((ext_vector_type(2)));
typedef unsigned u32x2 __attribute__((ext_vector_type(2)));
__device__ __forceinline__ void store8(bf16_t* p, const f32x4& a, const f32x4& b) { u32x4 w; w.x = cvt_pk_bf16(a[0], a[1]); w.y = cvt_pk_bf16(a[2], a[3]); w.z = cvt_pk_bf16(b[0], b[1]); w.w = cvt_pk_bf16(b[2], b[3]); *(u32x4*)p = w; }
__device__ __forceinline__ void store4(bf16_t* p, const f32x4& a) { u32x2 w; w.x = cvt_pk_bf16(a[0], a[1]); w.y = cvt_pk_bf16(a[2], a[3]); *(u32x2*)p = w; }
__device__ __forceinline__ float sigm(float x) { return __builtin_amdgcn_rcpf(1.f + __expf(-x)); }
__device__ __forceinline__ float gelu_t(float x) { const float t = 1.5957691216057308f * (x + 0.044715f * x * x * x); return x * sigm(t); }
struct EpiP {
    const float* ss; float* ss_out; const float* resid; float* hout; bf16_t* hb;
    bf16_t* o0; bf16_t* o1; bf16_t* o2; bf16_t* o3; const float* cs; float* vst;
};
template <int KIND> struct Epi {
    static constexpr bool PERM = true, AFTER_DRAIN = false;
    EpiP p;
    __device__ __forceinline__ void operator()(const f32x4 (&acc)[2][2][4][2], const Unit& u, int wr, int wc, int fr, int fq) const {
        const int colt = u.pn * BM + wc * 32 + 8 * fq;
#pragma unroll
        for (int ai = 0; ai < 2; ++ai)
#pragma unroll
            for (int m = 0; m < 4; ++m) {
                const int row = u.pm * BM + ai * HALF + wr * 64 + m * 16 + fr;
                float r = 1.f;
                if (KIND != 1 && KIND != 4) r = rsqrtf(p.ss[row] * (1.f / 1024.f) + 1e-6f);
                float sq = 0.f, s1 = 0.f;
#pragma unroll
                for (int bj = 0; bj < 2; ++bj) {
                    const int c0 = colt + bj * HALF;
                    f32x4 v0 = acc[ai][bj][m][0] * r, v1 = acc[ai][bj][m][1] * r;
                    if (KIND == 0) {
                        if (u.pn < 4) {
                            f32x4 o;
#pragma unroll
                            for (int j = 0; j < 4; ++j) o[j] = v0[j] * sigm(v1[j]);
                            store4(p.o0 + (size_t)row * 512 + (c0 >> 1), o);
                        } else if (u.pn < 16) {
                            const int qq = ((c0 - 1024) & 63) >> 3, pos = row & 2047;
                            const f32x4* t = (const f32x4*)(p.cs + ((size_t)pos * 32 + 4 * qq) * 2);
                            const f32x4 t0 = t[0], t1 = t[1];
                            const f32x4 cc = {t0[0], t0[2], t1[0], t1[2]}, sn = {t0[1], t0[3], t1[1], t1[3]};
                            f32x4 o1 = v0 * cc - v1 * sn, o2 = v1 * cc + v0 * sn;
                            if (u.pn < 10) { o1 = o1 * QSCALE; o2 = o2 * QSCALE; }
                            store8(p.o1 + (size_t)row * 3072 + (c0 - 1024), o1, o2);
                        } else {
                            store8(p.o2 + (size_t)row * 1536 + (c0 - 4096), v0, v1);
                        }
                    } else if (KIND == 1 || KIND == 4) {
                        const size_t off = (size_t)row * 1024 + c0;
                        if (KIND == 1) { const f32x4 r0 = *(const f32x4*)(p.resid + off), r1 = *(const f32x4*)(p.resid + off + 4); v0 = v0 + r0; v1 = v1 + r1; }
                        else { const u32x4 rb = *(const u32x4*)(p.hb + off);
                            v0[0] += __uint_as_float(rb.x << 16); v0[1] += __uint_as_float(rb.x & 0xffff0000u); v0[2] += __uint_as_float(rb.y << 16); v0[3] += __uint_as_float(rb.y & 0xffff0000u);
                            v1[0] += __uint_as_float(rb.z << 16); v1[1] += __uint_as_float(rb.z & 0xffff0000u); v1[2] += __uint_as_float(rb.w << 16); v1[3] += __uint_as_float(rb.w & 0xffff0000u); }
                        store8(p.o0 + off, v0, v1);
#pragma unroll
                        for (int j = 0; j < 4; ++j) sq += v0[j] * v0[j] + v1[j] * v1[j];
                    } else if (KIND == 2) {
#pragma unroll
                        for (int j = 0; j < 4; ++j) { float a = fmaxf(v0[j], 0.f), b = fmaxf(v1[j], 0.f); v0[j] = a * a; v1[j] = b * b; }
                        store8(p.o0 + (size_t)row * 4096 + c0, v0, v1);
                    } else {
                        if (u.pn < 2) store8(p.o0 + (size_t)row * 512 + c0, v0, v1);
                        else if (u.pn < 6) { const f32x4 o = v0 * v1; store4(p.o1 + (size_t)row * 512 + ((c0 - 512) >> 1), o); }
                        else if (u.pn < 8) {
#pragma unroll
                            for (int j = 0; j < 4; ++j) { v0[j] = gelu_t(v0[j]); v1[j] = gelu_t(v1[j]); }
                            store8(p.o2 + (size_t)row * 512 + (c0 - 1536), v0, v1);
                        } else {
                            bf16_t* vt = p.o3 + (size_t)(c0 - 2048) * ::M + row;
#pragma unroll
                            for (int j = 0; j < 4; ++j) { v0[j] = gelu_t(v0[j]); v1[j] = gelu_t(v1[j]); s1 += v0[j] + v1[j]; sq += v0[j] * v0[j] + v1[j] * v1[j]; }
#pragma unroll
                            for (int j = 0; j < 4; ++j) { vt[(size_t)j * ::M] = (bf16_t)(cvt_pk_bf16(v0[j], 0.f) & 0xffffu); vt[(size_t)(j + 4) * ::M] = (bf16_t)(cvt_pk_bf16(v1[j], 0.f) & 0xffffu); }
                        }
                    }
                }
                if (KIND == 1 || KIND == 4) {
                    sq += __shfl_xor(sq, 16); sq += __shfl_xor(sq, 32);
                    if (fq == 0) atomicAdd(p.ss_out + row, sq);
                }
                if (KIND == 3) {
                    if (u.pn >= 8) {
                        sq += __shfl_xor(sq, 16); sq += __shfl_xor(sq, 32); s1 += __shfl_xor(s1, 16); s1 += __shfl_xor(s1, 32);
                        if (fq == 0) { atomicAdd(p.vst + 2 * row, s1); atomicAdd(p.vst + 2 * row + 1, sq); }
                    }
                }
            }
    }
};
template <class Epi, class Sched, bool ALIGN_EPI = false, bool SP2 = false>
__device__ __forceinline__ void gemm_phase(PG8_LAS unsigned char* lds, const Gemm g, const Sched& S, const Epi& E) {
    int tid_ = threadIdx.x; asm volatile("" : "+v"(tid_));
    const int tid = tid_, wid = __builtin_amdgcn_readfirstlane(tid >> 6), lane = tid & 63, wr = wid >> 2, wc = wid & 3, fr = lane & 15, fq = lane >> 4;
    const int K = g.K, nt = K / BK;
    unsigned voffA[2], voffB[2];
#pragma unroll
    for (int i = 0; i < 2; ++i) { int R, C; stage_rc(tid * 16 + i * 8192, R, C); const int Rb = Epi::PERM ? ((R & ~31) + perm32(R & 31)) : R;
        voffA[i] = (unsigned)(R * K + C) * 2u; voffB[i] = (unsigned)(Rb * K + C) * 2u; }
    const size_t kstep = (size_t)(BK * 2);
    const size_t hstep = (size_t)HALF * K * 2;
    const size_t tstep = 2 * hstep;
    const unsigned ldsw = (unsigned)wid * 1024u;
    const int aoff = lds_byte(wr * 64 + fr, fq * 8), boff = lds_byte(wc * 32 + fr, fq * 8);
#define PG8_SA(b, h) (((b) * 2 + (h)) * HTB)
#define PG8_SB(b, h) ((4 + (b) * 2 + (h)) * HTB)
#define PG8_STAGE(bufoff, gbase, voff) do { _Pragma("unroll") for (int _i = 0; _i < 2; ++_i) \
        __builtin_amdgcn_global_load_lds((const unsigned*)((const char*)(gbase) + (voff)[_i]), (PG8_LAS unsigned*)(lds + (bufoff) + ldsw + _i * 8192), 16, 0, 0); } while (0)
#define PG8_LDA(dst, b, h) do { _Pragma("unroll") for (int m = 0; m < 4; ++m) _Pragma("unroll") for (int k = 0; k < 2; ++k) dst[m][k] = *(const PG8_LAS bf16x8*)(lds + PG8_SA(b, h) + aoff + m * 2048 + k * 1024); } while (0)
#define PG8_LDB(dst, b, h) do { _Pragma("unroll") for (int n = 0; n < 2; ++n) _Pragma("unroll") for (int k = 0; k < 2; ++k) dst[n][k] = *(const PG8_LAS bf16x8*)(lds + PG8_SB(b, h) + boff + n * 2048 + k * 1024); } while (0)
#define PG8_MMA(ai, bj, At, Bt) do { __builtin_amdgcn_s_setprio(1); _Pragma("unroll") for (int m = 0; m < 4; ++m) _Pragma("unroll") for (int n = 0; n < 2; ++n) _Pragma("unroll") for (int k = 0; k < 2; ++k) \
        acc[ai][bj][m][n] = __builtin_amdgcn_mfma_f32_16x16x32_bf16(Bt[n][k], At[m][k], acc[ai][bj][m][n], 0, 0, 0); __builtin_amdgcn_s_setprio(0); } while (0)
#define PG8_WAIT_V(n) asm volatile("s_waitcnt vmcnt(" #n ")" ::: "memory")
#define PG8_WAIT_L(n) asm volatile("s_waitcnt lgkmcnt(" #n ")" ::: "memory")
#define PG8_BAR __builtin_amdgcn_s_barrier()
#define PG8_SCHED __builtin_amdgcn_sched_barrier(0)
    Unit cur, nxt; int ui = 0;
    if (!S.next(0, cur)) return;
    f32x4 acc[2][2][4][2];
#pragma unroll
    for (int a = 0; a < 2; ++a)
#pragma unroll
        for (int b = 0; b < 2; ++b)
#pragma unroll
            for (int m = 0; m < 4; ++m)
#pragma unroll
                for (int n = 0; n < 2; ++n) acc[a][b][m][n] = (f32x4){0.f, 0.f, 0.f, 0.f};
    bf16x8 At[4][2], B0[2][2], B1[2][2];
    const char* cA = (const char*)g.A + (size_t)cur.pm * tstep; const char* cB = (const char*)g.Bt + (size_t)cur.pn * tstep;
    S.a_ready(cur);
    if constexpr (SP2) {
        PG8_STAGE(PG8_SB(0, 0), cB, voffB); PG8_STAGE(PG8_SB(0, 1), cB + hstep, voffB); PG8_STAGE(PG8_SA(0, 0), cA, voffA); PG8_STAGE(PG8_SA(0, 1), cA + hstep, voffA);
        if (wr == 1) PG8_BAR;
        PG8_WAIT_V(2); PG8_BAR;
        PG8_STAGE(PG8_SB(1, 0), cB + kstep, voffB); PG8_STAGE(PG8_SA(1, 0), cA + kstep, voffA); PG8_STAGE(PG8_SB(1, 1), cB + hstep + kstep, voffB);
        PG8_WAIT_V(6); PG8_BAR;
    } else {
        PG8_STAGE(PG8_SB(0, 0), cB, voffB); PG8_STAGE(PG8_SA(0, 0), cA, voffA); PG8_STAGE(PG8_SB(0, 1), cB + hstep, voffB); PG8_STAGE(PG8_SA(0, 1), cA + hstep, voffA);
        if (wr == 1) PG8_BAR;
        PG8_WAIT_V(4); PG8_BAR;
        PG8_STAGE(PG8_SB(1, 0), cB + kstep, voffB); PG8_STAGE(PG8_SA(1, 0), cA + kstep, voffA); PG8_STAGE(PG8_SB(1, 1), cB + hstep + kstep, voffB);
        PG8_WAIT_V(6); PG8_BAR;
    }
    for (;;) {
        const bool has_next = S.next(ui + 1, nxt);
        const char* nA = has_next ? (const char*)g.A + (size_t)nxt.pm * tstep : cA; const char* nB = has_next ? (const char*)g.Bt + (size_t)nxt.pn * tstep : cB;
        for (int t = 0; t < nt; t += 2) {
            const bool last = (t == nt - 2);
            const char* a1 = cA + (size_t)(t + 1) * kstep;
            const char* a2 = last ? nA : cA + (size_t)(t + 2) * kstep; const char* b2 = last ? nB : cB + (size_t)(t + 2) * kstep;
            const char* a3 = a2 + kstep; const char* b3 = b2 + kstep;
            if (last && has_next) S.a_ready(nxt);
            if constexpr (SP2) {
            PG8_LDB(B0, 0, 0); PG8_LDB(B1, 0, 1); PG8_SCHED; PG8_LDA(At, 0, 0); PG8_STAGE(PG8_SA(1, 1), a1 + hstep, voffA);
            PG8_WAIT_V(8); PG8_WAIT_L(0); PG8_BAR; PG8_MMA(0, 0, At, B0); PG8_MMA(0, 1, At, B1); PG8_BAR; PG8_SCHED;
            PG8_LDA(At, 0, 1); PG8_STAGE(PG8_SB(0, 0), b2, voffB); PG8_STAGE(PG8_SB(0, 1), b2 + hstep, voffB); PG8_STAGE(PG8_SA(0, 0), a2, voffA);
            PG8_WAIT_V(8); PG8_WAIT_L(0); PG8_BAR; PG8_MMA(1, 0, At, B0); PG8_MMA(1, 1, At, B1); PG8_BAR; PG8_SCHED;
            PG8_LDB(B0, 1, 0); PG8_LDB(B1, 1, 1); PG8_SCHED; PG8_LDA(At, 1, 0); PG8_STAGE(PG8_SA(0, 1), a2 + hstep, voffA);
            PG8_WAIT_V(8); PG8_WAIT_L(0); PG8_BAR; PG8_MMA(0, 0, At, B0); PG8_MMA(0, 1, At, B1); PG8_BAR; PG8_SCHED;
            PG8_LDA(At, 1, 1); PG8_STAGE(PG8_SB(1, 0), b3, voffB); PG8_STAGE(PG8_SB(1, 1), b3 + hstep, voffB); PG8_STAGE(PG8_SA(1, 0), a3, voffA);
            PG8_WAIT_V(8); PG8_WAIT_L(0); PG8_BAR; PG8_MMA(1, 0, At, B0); PG8_MMA(1, 1, At, B1); PG8_BAR; PG8_SCHED;
            } else {
            PG8_LDB(B0, 0, 0); PG8_SCHED; PG8_LDA(At, 0, 0); PG8_STAGE(PG8_SA(1, 1), a1 + hstep, voffA);
            PG8_WAIT_L(8); PG8_BAR; PG8_WAIT_L(0); PG8_MMA(0, 0, At, B0); PG8_BAR; PG8_SCHED;
            PG8_LDB(B1, 0, 1); PG8_STAGE(PG8_SB(0, 0), b2, voffB);
            PG8_BAR; PG8_WAIT_L(0); PG8_MMA(0, 1, At, B1); PG8_BAR;
            PG8_LDA(At, 0, 1); PG8_STAGE(PG8_SA(0, 0), a2, voffA);
            PG8_BAR; PG8_WAIT_L(0); PG8_MMA(1, 0, At, B0); PG8_BAR; PG8_SCHED;
            PG8_STAGE(PG8_SB(0, 1), b2 + hstep, voffB);
            PG8_WAIT_V(6); PG8_BAR; PG8_MMA(1, 1, At, B1); PG8_BAR;
            PG8_LDB(B0, 1, 0); PG8_SCHED; PG8_LDA(At, 1, 0); PG8_STAGE(PG8_SA(0, 1), a2 + hstep, voffA);
            PG8_WAIT_L(8); PG8_BAR; PG8_WAIT_L(0); PG8_MMA(0, 0, At, B0); PG8_BAR; PG8_SCHED;
            PG8_LDB(B1, 1, 1); PG8_STAGE(PG8_SB(1, 0), b3, voffB);
            PG8_BAR; PG8_WAIT_L(0); PG8_MMA(0, 1, At, B1); PG8_BAR;
            PG8_LDA(At, 1, 1); PG8_STAGE(PG8_SA(1, 0), a3, voffA);
            PG8_BAR; PG8_WAIT_L(0); PG8_MMA(1, 0, At, B0); PG8_BAR; PG8_SCHED;
            PG8_STAGE(PG8_SB(1, 1), b3 + hstep, voffB);
            PG8_WAIT_V(6); PG8_BAR; PG8_MMA(1, 1, At, B1); PG8_BAR;
            }
        }
        if constexpr (ALIGN_EPI) { if (wr == 0) PG8_BAR; }
        if constexpr (!Epi::AFTER_DRAIN) { E(acc, cur, wr, wc, fr, fq); S.done(cur); }
        if (!has_next) break;
#pragma unroll
        for (int a = 0; a < 2; ++a)
#pragma unroll
            for (int b = 0; b < 2; ++b)
#pragma unroll
                for (int m = 0; m < 4; ++m)
#pragma unroll
                    for (int n = 0; n < 2; ++n) acc[a][b][m][n] = (f32x4){0.f, 0.f, 0.f, 0.f};
        cur = nxt; cA = nA; cB = nB; ++ui;
        if constexpr (ALIGN_EPI) { if (wr == 1) PG8_BAR; }
    }
    PG8_WAIT_V(0);
    if constexpr (!ALIGN_EPI) { if (wr == 0) PG8_BAR; }
    PG8_BAR;
    if constexpr (Epi::AFTER_DRAIN) { E.fused(acc, cur, wr, wc, fr, fq, lds, wid, lane); S.done(cur); }
#undef PG8_SA
#undef PG8_SB
#undef PG8_STAGE
#undef PG8_LDA
#undef PG8_LDB
#undef PG8_MMA
#undef PG8_WAIT_V
#undef PG8_WAIT_L
#undef PG8_BAR
#undef PG8_SCHED
}
}
#define LAS __attribute__((address_space(3)))
typedef unsigned short bf16_t;
typedef short bf16x8 __attribute__((ext_vector_type(8)));
typedef short s16x4 __attribute__((ext_vector_type(4)));
typedef float f32x4 __attribute__((ext_vector_type(4)));
typedef float f32x16 __attribute__((ext_vector_type(16)));
typedef unsigned u32x4 __attribute__((ext_vector_type(4)));
typedef float f32x2_t __attribute__((ext_vector_type(2)));
typedef __bf16 bf16x2_t __attribute__((ext_vector_type(2)));
__device__ __forceinline__ unsigned pk2(float lo, float hi) { f32x2_t v = {lo, hi}; bf16x2_t b = __builtin_convertvector(v, bf16x2_t); return __builtin_bit_cast(unsigned, b); }
__device__ __forceinline__ float bf2f(unsigned short x) { return __uint_as_float((unsigned)x << 16); }
__device__ __forceinline__ float bflo(unsigned w) { return __uint_as_float(w << 16); }
__device__ __forceinline__ float bfhi(unsigned w) { return __uint_as_float(w & 0xffff0000u); }
__device__ __forceinline__ int crow(int r, int hi) { return (r & 3) + 8 * (r >> 2) + 4 * hi; }
__device__ __forceinline__ float wave_sum(float v) {
#pragma unroll
    for (int o = 1; o < 64; o <<= 1) v += __shfl_xor(v, o);
    return v;
}

#define GAS __attribute__((address_space(1)))
#define XB_TMO      128
#define XB_XCNT(j)  (256  + 64 * (j))
#define XB_XSUB(j)  (1280 + 64 * (j))
#define XB_XGEN(j)  (2304 + 64 * (j))
#define XB_TOP      3328
#define XB_TOPGEN   3392
#define XCD_BAR_WORDS 3456
#define XB_SPIN_CAP (1u << 18)

__device__ __forceinline__ unsigned xb_ld(unsigned* p)              { return __hip_atomic_load(p, __ATOMIC_RELAXED, __HIP_MEMORY_SCOPE_AGENT); }
__device__ __forceinline__ unsigned xb_add(unsigned* p, unsigned v) { return __hip_atomic_fetch_add(p, v, __ATOMIC_RELAXED, __HIP_MEMORY_SCOPE_AGENT); }
__device__ __forceinline__ unsigned xb_xcc_id() { return (unsigned)__builtin_amdgcn_s_getreg((3 << 11) | 20) & 0xFu; }
#define XB_SPIN(cond, bar) do { unsigned _sp = 0; while (cond) { __builtin_amdgcn_s_sleep(1); \
    if ((++_sp & 255u) == 0u) { if (xb_ld(&(bar)[XB_TMO])) break; if (_sp > XB_SPIN_CAP) { atomicAdd(&(bar)[XB_TMO], 1u); break; } } } } while (0)

struct XcdBarrier {
    unsigned* bar; unsigned x;
    volatile LAS unsigned* st;
};

__device__ __forceinline__ XcdBarrier xcd_barrier_post(unsigned* bar, volatile LAS unsigned* st) {
    XcdBarrier b; b.bar = bar; b.x = xb_xcc_id(); b.st = st;
    if (threadIdx.x == 0) (void)xb_add(&bar[XB_XCNT(b.x)], 1u);
    return b;
}
__device__ __forceinline__ void xcd_barrier_complete(unsigned* bar, unsigned x, unsigned& nloc, unsigned& nx) {
    const unsigned G = gridDim.x * gridDim.y * gridDim.z;
    unsigned sum, cnt, mine, sp = 0u;
    for (;;) {
        sum = 0u; cnt = 0u; mine = 0u;
#pragma unroll
        for (unsigned j = 0; j < 16; ++j) { const unsigned c = xb_ld(&bar[XB_XCNT(j)]); sum += c; cnt += (c > 0u) ? 1u : 0u; mine = (j == x) ? c : mine; }
        if (sum == G) break;
        __builtin_amdgcn_s_sleep(1);
        if ((++sp & 255u) == 0u) { if (xb_ld(&bar[XB_TMO])) break; if (sp > XB_SPIN_CAP) { atomicAdd(&bar[XB_TMO], 1u); break; } }
    }
    nloc = mine > 0u ? mine : 1u; nx = cnt > 0u ? cnt : 1u;
}

__device__ __forceinline__ void xcd_barrier(const XcdBarrier& b) {
    asm volatile("s_waitcnt vmcnt(0)" ::: "memory");
    __syncthreads();
    if (threadIdx.x == 0) {
        unsigned* bar = b.bar;
        __builtin_amdgcn_s_waitcnt(0);
        unsigned nloc = b.st[0], nx = b.st[1];
        if (nloc == 0u) { xcd_barrier_complete(bar, b.x, nloc, nx); b.st[0] = nloc; b.st[1] = nx; }
        const unsigned old = xb_add(&bar[XB_XSUB(b.x)], 1u);
        const unsigned gen = old / nloc;
        if (old + 1u == (gen + 1u) * nloc) {
            __builtin_amdgcn_fence(__ATOMIC_RELEASE, "agent");
            asm volatile("s_waitcnt vmcnt(0)" ::: "memory");
            const unsigned og = xb_add(&bar[XB_TOP], 1u);
            const unsigned tg = og / nx;
            if (og + 1u == (tg + 1u) * nx) xb_add(&bar[XB_TOPGEN], 1u);
            else XB_SPIN(xb_ld(&bar[XB_TOPGEN]) == tg, bar);
            __builtin_amdgcn_fence(__ATOMIC_ACQUIRE, "agent");
            xb_add(&bar[XB_XGEN(b.x)], 1u);
            asm volatile("s_waitcnt vmcnt(0)" ::: "memory");
        } else {
            XB_SPIN(xb_ld(&bar[XB_XGEN(b.x)]) == gen, bar);
            __builtin_amdgcn_fence(__ATOMIC_ACQUIRE, "agent");
            asm volatile("s_waitcnt vmcnt(0)" ::: "memory");
        }
    }
    __syncthreads();
}

struct Args { const float* in[19]; float* out; unsigned char* ws; };

__device__ __forceinline__ int perm_in0(int n) {
    if (n < 1024) { const int q8 = n >> 3, e = n & 7; return (e < 4) ? (4 * q8 + e) : (512 + 4 * q8 + (e - 4)); }
    if (n < 4096) { const int w = (n - 1024) & 63, hh = (n - 1024) >> 6, qq = w >> 3, e = w & 7; return 1024 + 64 * hh + 4 * qq + (e & 3) + ((e >= 4) ? 32 : 0); }
    return n;
}
__device__ __forceinline__ int perm_in1(int n) {
    if (n >= 512 && n < 1536) { const int mm = n - 512, q8 = mm >> 3, e = mm & 7; return (e < 4) ? (512 + 4 * q8 + e) : (1024 + 4 * q8 + (e - 4)); }
    return n;
}
struct TItem { const float* W; const float* kscale; bf16_t* WT; int K, N, perm, q; };
__device__ __forceinline__ int perm_any(int perm, int n) { return (perm == 1) ? perm_in0(n) : (perm == 2) ? perm_in1(n) : n; }
__device__ __forceinline__ void titem_load(const TItem& t, int lane, f32x4 (&v)[8]) {
    const int nblk = t.N / 32, kb = t.q / nblk, nb = t.q % nblk, k0 = 64 * kb, n0 = 32 * nb;
    const int kr = lane >> 3, n4 = lane & 7;
    const int ns = perm_any(t.perm, n0 + 4 * n4);
    const float* wp = t.W + (size_t)(k0 + kr) * t.N + ns;
#pragma unroll
    for (int i = 0; i < 8; ++i) v[i] = *(const f32x4*)(wp + (size_t)(8 * i) * t.N);
}
__device__ __forceinline__ void titem_finish(const TItem& t, int lane, const f32x4 (&v)[8], LAS float* scr) {
    const int nblk = t.N / 32, kb = t.q / nblk, nb = t.q % nblk, k0 = 64 * kb, n0 = 32 * nb;
    const int kr = lane >> 3, n4 = lane & 7;
#pragma unroll
    for (int i = 0; i < 8; ++i) { LAS float* d = scr + (kr + 8 * i) * 33 + 4 * n4; d[0] = v[i][0]; d[1] = v[i][1]; d[2] = v[i][2]; d[3] = v[i][3]; }
    asm volatile("s_waitcnt lgkmcnt(0)" ::: "memory");
    const int c = lane & 7;
    f32x4 ks0 = {1.f, 1.f, 1.f, 1.f}, ks1 = {1.f, 1.f, 1.f, 1.f};
    if (t.kscale) { ks0 = *(const f32x4*)(t.kscale + k0 + 8 * c); ks1 = *(const f32x4*)(t.kscale + k0 + 8 * c + 4); }
#pragma unroll
    for (int j = 0; j < 4; ++j) { const int n = (lane >> 3) + 8 * j; const LAS float* s = scr + (8 * c) * 33 + n;
        u32x4 o; o.x = pk2(s[0 * 33] * ks0[0], s[1 * 33] * ks0[1]); o.y = pk2(s[2 * 33] * ks0[2], s[3 * 33] * ks0[3]); o.z = pk2(s[4 * 33] * ks1[0], s[5 * 33] * ks1[1]); o.w = pk2(s[6 * 33] * ks1[2], s[7 * 33] * ks1[3]);
        *(u32x4*)(t.WT + (size_t)(n0 + n) * t.K + k0 + 8 * c) = o; }
    asm volatile("s_waitcnt lgkmcnt(0)" ::: "memory");
}

constexpr int I_IN0 = 16 * (NIN0 / 32), I_OUT = 16 * 32, I_W1 = 16 * (FF / 32), I_W2 = 64 * 32, I_IN1 = 16 * (NIN1 / 32);
constexpr int NITEMS = I_IN0 + I_OUT + I_W1 + I_W2 + I_IN1 + I_OUT + I_W1 + I_W2;
constexpr int ITEMS_B1 = I_IN0 + I_OUT + I_W1 + I_W2 + I_IN1 + I_OUT;
__device__ __forceinline__ TItem titem_decode(const Args& args, unsigned char* ws, int it) {
    int q = it;
    if (q < I_IN0) return TItem{args.in[3], args.in[1], (bf16_t*)(ws + WS_WIN0), 1024, NIN0, 1, q}; q -= I_IN0;
    if (q < I_OUT) return TItem{args.in[8], nullptr, (bf16_t*)(ws + WS_WOUT0), 1024, 1024, 0, q}; q -= I_OUT;
    if (q < I_W1) return TItem{args.in[16], args.in[2], (bf16_t*)(ws + WS_W1_0), 1024, FF, 0, q}; q -= I_W1;
    if (q < I_W2) return TItem{args.in[17], nullptr, (bf16_t*)(ws + WS_W2_0), FF, 1024, 0, q}; q -= I_W2;
    if (q < I_IN1) return TItem{args.in[9], args.in[1] + 1024, (bf16_t*)(ws + WS_WIN1), 1024, NIN1, 2, q}; q -= I_IN1;
    if (q < I_OUT) return TItem{args.in[15], nullptr, (bf16_t*)(ws + WS_WOUT1), 1024, 1024, 0, q}; q -= I_OUT;
    if (q < I_W1) return TItem{args.in[16] + (size_t)1024 * FF, args.in[2] + 1024, (bf16_t*)(ws + WS_W1_1), 1024, FF, 0, q}; q -= I_W1;
    return TItem{args.in[17] + (size_t)FF * 1024, nullptr, (bf16_t*)(ws + WS_W2_1), FF, 1024, 0, q};
}
__device__ __forceinline__ void convert_items(const Args& args, unsigned char* ws, int lo, int hi, int widx, int nw, int lane, LAS float* scr) {
    for (int it = lo + widx; it < hi; it += 3 * nw) {
        f32x4 va[8], vb[8], vc[8]; TItem ta = titem_decode(args, ws, it), tb{}, tc{};
        const bool hb = it + nw < hi, hc = it + 2 * nw < hi;
        titem_load(ta, lane, va);
        if (hb) { tb = titem_decode(args, ws, it + nw); titem_load(tb, lane, vb); }
        if (hc) { tc = titem_decode(args, ws, it + 2 * nw); titem_load(tc, lane, vc); }
        titem_finish(ta, lane, va, scr);
        if (hb) titem_finish(tb, lane, vb, scr);
        if (hc) titem_finish(tc, lane, vc, scr);
    }
}
__device__ __forceinline__ void bubble_convert(const Args& args, unsigned char* ws, int nwg, int lo, int hi, LAS unsigned char* lds) {
    const int G = gridDim.x, c = blockIdx.x, rem = nwg % G;
    const int lane = threadIdx.x & 63, wave = __builtin_amdgcn_readfirstlane(threadIdx.x >> 6);
    LAS float* scr = (LAS float*)(lds + wave * 16384);
    if (rem == 0) convert_items(args, ws, lo, hi, c * 8 + wave, G * 8, lane, scr);
    else if (c >= rem) convert_items(args, ws, lo, hi, (c - rem) * 8 + wave, (G - rem) * 8, lane, scr);
}

__device__ __forceinline__ s16x4 vtr(const LAS unsigned char* p) { typedef short v4i16_t __attribute__((ext_vector_type(4))); return __builtin_bit_cast(s16x4, __builtin_amdgcn_ds_read_tr16_b64_v4i16((LAS v4i16_t*)p)); }
__device__ __forceinline__ void attn_wave_unit(bf16_t* QK, const bf16_t* Vb, float* lse2, int b, int g, int h, int r, int i0, LAS unsigned char* vl, int lane) {
    const int dil = (g == 0) ? 1 : (g == 1 ? 4 : 16);
    const int hh = g * 8 + h, ql = lane & 31, hi = lane >> 5;
    const size_t rowbase = (size_t)b * SEQ + r;
    const bf16_t* qp = QK + (rowbase + (size_t)(i0 + ql) * dil) * 3072 + hh * 64 + hi * 8;
    bf16x8 qf[4];
#pragma unroll
    for (int s = 0; s < 4; ++s) qf[s] = *(const bf16x8*)(qp + 16 * s);
    bf16x8 kf[5][4];
#pragma unroll
    for (int j = 0; j < 5; ++j) {
        int kr = i0 - 128 + 32 * j + ql; kr = kr < 0 ? 0 : kr;
        const bf16_t* kp = QK + (rowbase + (size_t)kr * dil) * 3072 + 1536 + hh * 64 + hi * 8;
#pragma unroll
        for (int s = 0; s < 4; ++s) kf[j][s] = *(const bf16x8*)(kp + 16 * s);
    }
    u32x4 vr[5][4];
#pragma unroll
    for (int j = 0; j < 5; ++j)
#pragma unroll
        for (int i = 0; i < 4; ++i) { int rk = i0 - 128 + 32 * j + 8 * i + (lane >> 3); rk = rk < 0 ? 0 : rk;
            vr[j][i] = *(const u32x4*)(Vb + (rowbase + (size_t)rk * dil) * 1536 + hh * 64 + (lane & 7) * 8); }
    f32x16 S[5];
    const float NEG = -INFINITY;
#pragma unroll
    for (int j = 0; j < 5; ++j) {
        const bool tv = (i0 - 128 + 32 * j) >= 0;
        f32x16 acc = {};
#pragma unroll
        for (int s = 0; s < 4; ++s) acc = __builtin_amdgcn_mfma_f32_32x32x16_bf16(kf[j][s], qf[s], acc, 0, 0, 0);
#pragma unroll
        for (int rr = 0; rr < 16; ++rr) {
            bool ok = tv;
            if (j == 0) ok = ok && (crow(rr, hi) >= ql);
            if (j == 4) ok = ok && (crow(rr, hi) <= ql);
            acc[rr] = ok ? acc[rr] : NEG;
        }
        S[j] = acc;
    }
    float mx = NEG;
#pragma unroll
    for (int j = 0; j < 5; ++j)
#pragma unroll
        for (int rr = 0; rr < 16; ++rr) mx = fmaxf(mx, S[j][rr]);
    mx = fmaxf(mx, __shfl_xor(mx, 32));
    float l = 0.f;
#pragma unroll
    for (int j = 0; j < 5; ++j)
#pragma unroll
        for (int rr = 0; rr < 16; ++rr) { const float pe = __builtin_amdgcn_exp2f(S[j][rr] - mx); S[j][rr] = pe; l += pe; }
    l += __shfl_xor(l, 32);
    const float inv = 1.f / l;
    if (hi == 0) lse2[((size_t)g * M + rowbase + (size_t)(i0 + ql) * dil) * 8 + h] = mx + __builtin_amdgcn_logf(l);
    f32x16 O0 = {}, O1 = {};
    const int li = lane & 15, gq = li >> 2, gp = li & 3, chh = (lane >> 4) & 1;
#pragma unroll
    for (int j = 0; j < 5; ++j) {
        LAS unsigned char* vb_ = vl + (j & 1) * 4096;
#pragma unroll
        for (int i = 0; i < 4; ++i) *(LAS u32x4*)(vb_ + (8 * i + (lane >> 3)) * 128 + (lane & 7) * 16) = vr[j][i];
        asm volatile("s_waitcnt lgkmcnt(0)" ::: "memory");
#pragma unroll
        for (int s = 0; s < 2; ++s) {
            u32x4 pw;
            pw.x = pk2(S[j][8 * s + 0] * inv, S[j][8 * s + 1] * inv); pw.y = pk2(S[j][8 * s + 2] * inv, S[j][8 * s + 3] * inv);
            pw.z = pk2(S[j][8 * s + 4] * inv, S[j][8 * s + 5] * inv); pw.w = pk2(S[j][8 * s + 6] * inv, S[j][8 * s + 7] * inv);
            const bf16x8 pa = __builtin_bit_cast(bf16x8, pw);
#pragma unroll
            for (int db = 0; db < 2; ++db) {
                const LAS unsigned char* a1 = vb_ + (16 * s + 4 * hi + gq) * 128 + (32 * db + 16 * chh + 4 * gp) * 2;
                const s16x4 lo = vtr(a1), hv = vtr(a1 + 8 * 128);
                const bf16x8 vb = {lo[0], lo[1], lo[2], lo[3], hv[0], hv[1], hv[2], hv[3]};
                if (db == 0) O0 = __builtin_amdgcn_mfma_f32_32x32x16_bf16(pa, vb, O0, 0, 0, 0);
                else O1 = __builtin_amdgcn_mfma_f32_32x32x16_bf16(pa, vb, O1, 0, 0, 0);
            }
        }
    }
    asm volatile("s_waitcnt lgkmcnt(0)" ::: "memory");
#pragma unroll
    for (int rr = 0; rr < 16; ++rr) { const int q = crow(rr, hi);
        *(LAS bf16_t*)(vl + q * 128 + ql * 2) = (bf16_t)(pk2(O0[rr], 0.f) & 0xffffu);
        *(LAS bf16_t*)(vl + q * 128 + (32 + ql) * 2) = (bf16_t)(pk2(O1[rr], 0.f) & 0xffffu); }
    asm volatile("s_waitcnt lgkmcnt(0)" ::: "memory");
#pragma unroll
    for (int i = 0; i < 4; ++i) { const int rq = 8 * i + (lane >> 3), ch = lane & 7;
        const u32x4 v = *(const LAS u32x4*)(vl + rq * 128 + ch * 16);
        *(u32x4*)(QK + (rowbase + (size_t)(i0 + rq) * dil) * 3072 + hh * 64 + ch * 8) = v; }
    asm volatile("s_waitcnt lgkmcnt(0)" ::: "memory");
}

__device__ __forceinline__ float transpose_reduce32(float (&a)[32], int lane) {
#pragma unroll
    for (int n = 16; n >= 1; n >>= 1) {
        const bool bit = (lane & n) != 0;
#pragma unroll
        for (int i = 0; i < n; ++i) { const float lo = a[i], hv = a[i + n]; const float send = bit ? lo : hv, keep = bit ? hv : lo; a[i] = keep + __shfl_xor(send, n); }
    }
    return a[0] + __shfl_xor(a[0], 32);
}

__global__ void __launch_bounds__(512, 2) mk_fwd(Args args) {
    extern __shared__ __attribute__((aligned(16))) unsigned char lds_raw[];
    LAS unsigned char* lds = (LAS unsigned char*)lds_raw;
    const int tid = threadIdx.x, lane = tid & 63, wave = __builtin_amdgcn_readfirstlane(tid >> 6);
    const int G = gridDim.x, bx = blockIdx.x;
    const int vcu = (G % 8 == 0) ? (bx % 8) * (G / 8) + bx / 8 : bx;
    const int gw = vcu * 8 + wave, NGW = G * 8;
    const int gtid = bx * 512 + tid, NT = G * 512;
    unsigned char* ws = args.ws;
#if defined(PROBE_LO)
#ifndef PROBE_Q
#define PROBE_Q 1.0f
#endif
#define TSB ((unsigned long long*)(args.ws + 65536))
#define STAMP(k) do { if (blockIdx.x == 0 && threadIdx.x == 0) TSB[k] = __builtin_amdgcn_s_memrealtime(); } while (0)
#define STAMPB(k, b) do { if (blockIdx.x == (b) && threadIdx.x == 0) TSB[k] = __builtin_amdgcn_s_memrealtime(); } while (0)
    STAMP(0);
#else
#define STAMP(k) do {} while (0)
#define STAMPB(k, b) do {} while (0)
#endif
    for (int u = tid; u < (LDS_BYTES - 131072) / 4; u += 512) ((LAS unsigned*)(lds + 131072))[u] = 0u;
    __syncthreads();
    volatile LAS unsigned* MISC = (volatile LAS unsigned*)(lds + 131072 + 320);
    unsigned* ctl = (unsigned*)(ws + WS_CTL);
    const XcdBarrier bar = xcd_barrier_post(ctl, MISC + 8);
    const float* x = args.in[0];
    float* out = args.out;
    float* cs = (float*)(ws + WS_CS);
    float* ss = (float*)(ws + WS_SS);
    float* vst = (float*)(ws + WS_VST);
    float* lse2 = (float*)(ws + WS_LSE);
    bf16_t* Win0 = (bf16_t*)(ws + WS_WIN0); bf16_t* Wout0 = (bf16_t*)(ws + WS_WOUT0); bf16_t* W1_0 = (bf16_t*)(ws + WS_W1_0); bf16_t* W2_0 = (bf16_t*)(ws + WS_W2_0);
    bf16_t* Win1 = (bf16_t*)(ws + WS_WIN1); bf16_t* Wout1 = (bf16_t*)(ws + WS_WOUT1); bf16_t* W1_1 = (bf16_t*)(ws + WS_W1_1); bf16_t* W2_1 = (bf16_t*)(ws + WS_W2_1);
    bf16_t* R1 = (bf16_t*)(ws + WS_R1); bf16_t* GLU = (bf16_t*)(ws + WS_GLU); bf16_t* H1B = (bf16_t*)(ws + WS_H1B);
    bf16_t* QK = (bf16_t*)(ws + WS_QK); bf16_t* VB = (bf16_t*)(ws + WS_V); bf16_t* U = (bf16_t*)(ws + WS_U);
    bf16_t* GB = (bf16_t*)(ws + WS_GB); bf16_t* GG = (bf16_t*)(ws + WS_G); bf16_t* UB = (bf16_t*)(ws + WS_UB); bf16_t* VT = (bf16_t*)(ws + WS_VT); bf16_t* MIX1 = (bf16_t*)(ws + WS_MIX1);

    {
        for (int i = gtid; i < 4 * M + 2 * M; i += NT) { if (i < 4 * M) ss[M + i] = 0.f; else vst[i - 4 * M] = 0.f; }
        for (int i = gtid; i < SEQ * 32; i += NT) { const int s = i >> 5, f = i & 31; const float inv = powf(10000.0f, -(float)f / 32.0f); const float ang = (float)s * inv; float sn, c; sincosf(ang, &sn, &c); cs[2 * i] = c; cs[2 * i + 1] = sn; }
        { float* ckT = (float*)(ws + WS_CKT); const float* ck_ = args.in[4]; for (int i = gtid; i < 512 * 32; i += NT) { const int c_ = i >> 5, j_ = i & 31; ckT[i] = (j_ < 31) ? ck_[j_ * 512 + c_] : 0.f; } }
        LAS float* scr = (LAS float*)(lds + wave * 16384);
        convert_items(args, ws, 0, I_IN0, gw, NGW, lane, scr);
        for (int row0 = gw * 4; row0 < M; row0 += NGW * 4) {
            f32x4 v[4][4];
#pragma unroll
            for (int rr = 0; rr < 4; ++rr)
#pragma unroll
                for (int j = 0; j < 4; ++j) v[rr][j] = ((const f32x4*)(x + (size_t)(row0 + rr) * 1024) + lane)[64 * j];
#pragma unroll
            for (int rr = 0; rr < 4; ++rr) { float sq = 0.f; unsigned long long* o8 = (unsigned long long*)(R1 + (size_t)(row0 + rr) * 1024) + lane;
#pragma unroll
                for (int j = 0; j < 4; ++j) { const f32x4 w = v[rr][j]; sq += (w[0] * w[0] + w[1] * w[1]) + (w[2] * w[2] + w[3] * w[3]); o8[64 * j] = (unsigned long long)pk2(w[0], w[1]) | ((unsigned long long)pk2(w[2], w[3]) << 32); }
                sq = wave_sum(sq); if (lane == 0) ss[row0 + rr] = sq; }
        }
    }
    xcd_barrier(bar);
    STAMP(1);
    {
        pg8::Gemm g{R1, Win0, M, NIN0, 1024}; pg8::StaticOrder S; S.init(M, NIN0, G, bx);
        pg8::EpiP p{}; p.ss = ss; p.o0 = GLU; p.o1 = QK; p.o2 = VB; p.cs = cs;
        pg8::Epi<0> E{p};
        pg8::gemm_phase<pg8::Epi<0>, pg8::StaticOrder, true, true>(lds, g, S, E);
        STAMPB(40, 200); STAMPB(42, 0);
        bubble_convert(args, ws, (M / 256) * (NIN0 / 256), I_IN0, ITEMS_B1, lds);
        STAMPB(41, 200);
    }
    xcd_barrier(bar);
    STAMP(2);
    {
#ifndef NO_ATTN
        for (int unit = vcu; unit < 256; unit += G) {
            const int b = unit >> 5, h = (unit >> 2) & 7, tb = unit & 3;
            LAS unsigned char* vl = lds + wave * 8192;
#pragma unroll 1
            for (int k = 0; k < 6; ++k) {
                const int wu = __builtin_amdgcn_readfirstlane(k * 8 + wave);
                const int g = wu >> 4, e = wu & 15;
                int r, i0;
                if (g == 0) { r = 0; i0 = tb * 512 + 32 * e; }
                else if (g == 1) { r = e & 3; i0 = tb * 128 + 32 * (e >> 2); }
                else { r = e; i0 = tb * 32; }
                attn_wave_unit(QK, VB, lse2, b, g, h, r, i0, vl, lane);
            }
            asm volatile("s_waitcnt vmcnt(0)" ::: "memory");
            __syncthreads();
            STAMP(20);
#pragma unroll 2
            for (int it = 0; it < 8; ++it) {
                const int tl = it * 64 + (tid >> 3), ch = tid & 7; const size_t row = (size_t)b * SEQ + tb * 512 + tl;
                const float l0 = lse2[((size_t)0 * M + row) * 8 + h], l1 = lse2[((size_t)1 * M + row) * 8 + h], l2 = lse2[((size_t)2 * M + row) * 8 + h];
                const float mxl = fmaxf(l0, fmaxf(l1, l2));
                float e0 = __builtin_amdgcn_exp2f(l0 - mxl), e1 = __builtin_amdgcn_exp2f(l1 - mxl), e2 = __builtin_amdgcn_exp2f(l2 - mxl);
                const float inv = 1.f / (e0 + e1 + e2); e0 *= inv; e1 *= inv; e2 *= inv;
                const u32x4 a0 = *(const u32x4*)(QK + row * 3072 + (0 + h) * 64 + ch * 8), a1 = *(const u32x4*)(QK + row * 3072 + (8 + h) * 64 + ch * 8), a2 = *(const u32x4*)(QK + row * 3072 + (16 + h) * 64 + ch * 8);
                u32x4 o;
#pragma unroll
                for (int w = 0; w < 4; ++w) o[w] = pk2(e0 * bflo(a0[w]) + e1 * bflo(a1[w]) + e2 * bflo(a2[w]), e0 * bfhi(a0[w]) + e1 * bfhi(a1[w]) + e2 * bfhi(a2[w]));
                *(u32x4*)(R1 + row * 1024 + 512 + h * 64 + ch * 8) = o;
            }
            __syncthreads();
        }
    STAMP(21);
#endif
#ifndef NO_CONV
        const float* cb = args.in[5]; const float* lg = args.in[6]; const float* lb = args.in[7];
        LAS float* part = (LAS float*)(lds + 65536); LAS float* stat = (LAS float*)(lds + 65536 + 4096);
        for (int tile = vcu; tile < 512; tile += G) {
            int tidc = threadIdx.x; asm volatile("" : "+v"(tidc));
            const int t0 = tile * 32, tseq = t0 & 2047;
            {
                const int ch = tidc & 63, r0 = tidc >> 6;
                const bf16_t* gp = GLU + (size_t)(t0 - 30 + r0) * 512 + ch * 8;
                LAS unsigned char* lp = lds + r0 * 1024 + ch * 16;
                u32x4 sv[8];
#pragma unroll
                for (int it = 0; it < 8; ++it) sv[it] = *(const u32x4*)(gp + (size_t)it * 8 * 512);
#pragma unroll
                for (int it = 0; it < 8; ++it) { const bool ok = (tseq - 30 + r0 + 8 * it) >= 0; u32x4 v = sv[it]; v.x = ok ? v.x : 0u; v.y = ok ? v.y : 0u; v.z = ok ? v.z : 0u; v.w = ok ? v.w : 0u; *(LAS u32x4*)(lp + it * 8192) = v; }
            }
            __syncthreads();
            const int c = tidc;
            float o[32];
            {
                float kk[32];
                { const f32x4* kp4 = (const f32x4*)((const float*)(ws + WS_CKT) + c * 32);
#pragma unroll
                  for (int j4 = 0; j4 < 8; ++j4) { const f32x4 kq = kp4[j4]; kk[4 * j4] = kq[0]; kk[4 * j4 + 1] = kq[1]; kk[4 * j4 + 2] = kq[2]; kk[4 * j4 + 3] = kq[3]; } }
                const float bias = cb[c];
                float xv[62];
#pragma unroll
                for (int i = 0; i < 46; ++i) xv[i] = bf2f(*(const LAS bf16_t*)(lds + i * 1024 + c * 2));
#pragma unroll
                for (int t = 0; t < 16; ++t) { float acc = bias;
#pragma unroll
                    for (int j = 0; j < 31; ++j) acc += kk[j] * xv[t + j];
                    o[t] = acc; }
                asm volatile("" ::: "memory");
#pragma unroll
                for (int i = 46; i < 62; ++i) xv[i] = bf2f(*(const LAS bf16_t*)(lds + i * 1024 + c * 2));
#pragma unroll
                for (int t = 16; t < 32; ++t) { float acc = bias;
#pragma unroll
                    for (int j = 0; j < 31; ++j) acc += kk[j] * xv[t + j];
                    o[t] = acc; }
            }
            {
                float a[32];
#pragma unroll
                for (int t = 0; t < 32; ++t) a[t] = o[t];
                const float s1 = transpose_reduce32(a, lane);
#pragma unroll
                for (int t = 0; t < 32; ++t) a[t] = o[t] * o[t];
                const float s2 = transpose_reduce32(a, lane);
                if (lane < 32) { part[(lane * 8 + wave) * 2] = s1; part[(lane * 8 + wave) * 2 + 1] = s2; }
            }
            __syncthreads();
            if (tidc < 32) { float s1 = 0.f, s2 = 0.f;
#pragma unroll
                for (int w = 0; w < 8; ++w) { s1 += part[(tidc * 8 + w) * 2]; s2 += part[(tidc * 8 + w) * 2 + 1]; }
                const float mean = s1 * (1.f / 512.f), var = s2 * (1.f / 512.f) - mean * mean;
                stat[2 * tidc] = mean; stat[2 * tidc + 1] = rsqrtf(fmaxf(var, 0.f) + EPS); }
            __syncthreads();
            const float lgc = lg[c], lbc = lb[c];
#pragma unroll
            for (int t = 0; t < 32; ++t) { const float mean = stat[2 * t], rstd = stat[2 * t + 1]; const float y = (o[t] - mean) * rstd * lgc + lbc; const float a = y * pg8::sigm(y);
                *(LAS bf16_t*)(lds + t * 1024 + c * 2) = (bf16_t)(pk2(a, 0.f) & 0xffffu); }
            __syncthreads();
            for (int idx = tidc; idx < 32 * 64; idx += 512) { const int rr = idx >> 6, ch = idx & 63; const u32x4 v = *(const LAS u32x4*)(lds + rr * 1024 + ch * 16); *(u32x4*)(R1 + (size_t)(t0 + rr) * 1024 + ch * 8) = v; }
            __syncthreads();
        }
#endif
    }
    xcd_barrier(bar);
    STAMP(3);
    {
        pg8::Gemm g{R1, Wout0, M, 1024, 1024}; pg8::StaticOrder S; S.init(M, 1024, G, bx);
        pg8::EpiP p{}; p.resid = x; p.o0 = H1B; p.ss_out = ss + M;
        pg8::Epi<1> E{p};
        pg8::gemm_phase<pg8::Epi<1>, pg8::StaticOrder, true, true>(lds, g, S, E);
    }
    xcd_barrier(bar);
    STAMP(4);
    {
        pg8::Gemm g{H1B, W1_0, M, FF, 1024}; pg8::StaticOrder S; S.init(M, FF, G, bx);
        pg8::EpiP p{}; p.ss = ss + M; p.o0 = U;
        pg8::Epi<2> E{p};
        pg8::gemm_phase<pg8::Epi<2>, pg8::StaticOrder, true, true>(lds, g, S, E);
    }
    xcd_barrier(bar);
    STAMP(5);
    {
        pg8::Gemm g{U, W2_0, M, 1024, FF}; pg8::StaticOrder S; S.init(M, 1024, G, bx);
        pg8::EpiP p{}; p.hb = H1B; p.o0 = R1; p.ss_out = ss + 2 * M;
        pg8::Epi<4> E{p};
        pg8::gemm_phase<pg8::Epi<4>, pg8::StaticOrder, true, true>(lds, g, S, E);
    }
    xcd_barrier(bar);
    STAMP(6);
    {
        pg8::Gemm g{R1, Win1, M, NIN1, 1024}; pg8::StaticOrder S; S.init(M, NIN1, G, bx);
        pg8::EpiP p{}; p.ss = ss + 2 * M; p.o0 = GB; p.o1 = GG; p.o2 = UB; p.o3 = VT; p.vst = vst;
        pg8::Epi<3> E{p};
        pg8::gemm_phase<pg8::Epi<3>, pg8::StaticOrder, true, true>(lds, g, S, E);
        bubble_convert(args, ws, (M / 256) * (NIN1 / 256), ITEMS_B1, NITEMS, lds);
    }
    xcd_barrier(bar);
    STAMP(7);
    {
        const float* sk = args.in[10]; const float* lg = args.in[11]; const float* lb = args.in[12]; const float* sgw = args.in[13]; const float* sgb = args.in[14];
#pragma unroll 2
        for (int idx = gtid; idx < M * 64; idx += NT) {
            const int row = idx >> 6, ch = idx & 63, tseq = row & 2047;
            const u32x4 gbv = *(const u32x4*)(GB + (size_t)row * 512 + ch * 8);
            u32x4 gv[3];
#pragma unroll
            for (int j = 0; j < 3; ++j) { const int rj = (tseq - 2 + j >= 0) ? (row - 2 + j) : row; gv[j] = *(const u32x4*)(GG + (size_t)rj * 512 + ch * 8); }
            float acc[8];
#pragma unroll
            for (int e = 0; e < 8; ++e) acc[e] = 0.f;
#pragma unroll
            for (int j = 0; j < 3; ++j) {
                const float okf = (tseq - 2 + j >= 0) ? 1.f : 0.f;
                const f32x4 k0 = *(const f32x4*)(sk + j * 512 + ch * 8) * okf, k1 = *(const f32x4*)(sk + j * 512 + ch * 8 + 4) * okf;
                acc[0] += k0[0] * bflo(gv[j][0]); acc[1] += k0[1] * bfhi(gv[j][0]); acc[2] += k0[2] * bflo(gv[j][1]); acc[3] += k0[3] * bfhi(gv[j][1]);
                acc[4] += k1[0] * bflo(gv[j][2]); acc[5] += k1[1] * bfhi(gv[j][2]); acc[6] += k1[2] * bflo(gv[j][3]); acc[7] += k1[3] * bfhi(gv[j][3]);
            }
            u32x4 o;
#pragma unroll
            for (int w = 0; w < 4; ++w) o[w] = pk2(bflo(gbv[w]) * acc[2 * w], bfhi(gbv[w]) * acc[2 * w + 1]);
            *(u32x4*)(MIX1 + (size_t)row * 1024 + ch * 8) = o;
        }
#ifndef NO_SGU
        constexpr int WP = 132;
        LAS float* Wl = (LAS float*)lds; LAS float* RS = (LAS float*)(lds + 69632); LAS float* MU = RS + 128; LAS float* RHO = RS + 256; LAS float* SIG = RS + 384;
        LAS bf16_t* ost = (LAS bf16_t*)(lds + 73728) + wave * 2048;
        int gi_l = -1;
        for (int unit = vcu; unit < 512; unit += G) {
            int tids = threadIdx.x; asm volatile("" : "+v"(tids));
            const int lane_s = tids & 63, ql = lane_s & 31, hi = lane_s >> 5;
            const int n = unit >> 2, gi = unit & 3, tok0 = n * 128;
            const int tr = wave >> 1, tc0 = (wave & 1) * 2;
            const bf16_t* vp0 = VT + ((size_t)gi * 128 + 32 * tc0 + ql) * M + tok0 + 8 * hi;
            bf16x8 b0[8], b1[8];
#pragma unroll
            for (int st = 0; st < 8; ++st) { b0[st] = *(const bf16x8*)(vp0 + 16 * st); b1[st] = *(const bf16x8*)(vp0 + (size_t)32 * M + 16 * st); }
            if (gi != gi_l) {
                __syncthreads();
                const f32x4* wsrc = (const f32x4*)(sgw + (size_t)gi * 128 * 128);
#pragma unroll
                for (int i = 0; i < 8; ++i) { const int e4 = tids + 512 * i, rw = e4 >> 5, c4 = e4 & 31; *(LAS f32x4*)(Wl + rw * WP + 4 * c4) = wsrc[e4]; }
                gi_l = gi;
            }
            if (tids < 128) { const float sm = vst[2 * (tok0 + tids)], sq = vst[2 * (tok0 + tids) + 1]; const float mean = sm * (1.f / 512.f), var = sq * (1.f / 512.f) - mean * mean;
                RS[tids] = rsqrtf(fmaxf(var, 0.f) + EPS); MU[tids] = mean; }
            __syncthreads();
            {
                const int t = tids >> 2, part = tids & 3; float sg = 0.f, rho = 0.f;
#pragma unroll 8
                for (int i = 0; i < 32; ++i) { const int sidx = part + 4 * i; const float w = (sidx <= t) ? Wl[t * WP + sidx] : 0.f; sg += w; rho += w * RS[sidx] * MU[sidx]; }
                sg += __shfl_xor(sg, 1); sg += __shfl_xor(sg, 2); rho += __shfl_xor(rho, 1); rho += __shfl_xor(rho, 2);
                if (part == 0) { RHO[t] = rho; SIG[t] = sg; }
            }
            f32x16 D0 = {}, D1 = {};
            const int t = 32 * tr + ql;
#pragma unroll
            for (int st = 0; st < 8; ++st) {
                const int sb = 16 * st + 8 * hi;
                const f32x4 w0 = *(const LAS f32x4*)(Wl + t * WP + sb), w1 = *(const LAS f32x4*)(Wl + t * WP + sb + 4);
                const f32x4 r0 = *(const LAS f32x4*)(RS + sb), r1 = *(const LAS f32x4*)(RS + sb + 4);
                float av[8];
#pragma unroll
                for (int j = 0; j < 4; ++j) { av[j] = (sb + j <= t) ? w0[j] * r0[j] : 0.f; av[j + 4] = (sb + 4 + j <= t) ? w1[j] * r1[j] : 0.f; }
                u32x4 aw; aw.x = pk2(av[0], av[1]); aw.y = pk2(av[2], av[3]); aw.z = pk2(av[4], av[5]); aw.w = pk2(av[6], av[7]);
                const bf16x8 af = __builtin_bit_cast(bf16x8, aw);
                D0 = __builtin_amdgcn_mfma_f32_32x32x16_bf16(af, b0[st], D0, 0, 0, 0);
                D1 = __builtin_amdgcn_mfma_f32_32x32x16_bf16(af, b1[st], D1, 0, 0, 0);
            }
            __syncthreads();
#pragma unroll
            for (int q = 0; q < 2; ++q) {
                const int chn = gi * 128 + 32 * (tc0 + q) + ql; const float lgc = lg[chn], lbc = lb[chn];
#pragma unroll
                for (int rr = 0; rr < 16; ++rr) { const int tl = crow(rr, hi), tt = 32 * tr + tl;
                    const float dv = (q == 0) ? D0[rr] : D1[rr];
                    ost[tl * 64 + 32 * q + ql] = (bf16_t)(pk2(lgc * (dv - RHO[tt]) + lbc * SIG[tt] + sgb[gi * 128 + tt], 0.f) & 0xffffu); }
            }
            asm volatile("s_waitcnt lgkmcnt(0)" ::: "memory");
#pragma unroll
            for (int i = 0; i < 4; ++i) { const int rw = 8 * i + (lane_s >> 3), c8 = lane_s & 7; const size_t token = (size_t)tok0 + 32 * tr + rw; const int chb = gi * 128 + 32 * tc0 + 8 * c8;
                const u32x4 uu = *(const u32x4*)(UB + token * 512 + chb);
                const u32x4 gg = *(const LAS u32x4*)(ost + rw * 64 + 8 * c8);
                u32x4 o; o.x = pk2(bflo(uu.x) * bflo(gg.x), bfhi(uu.x) * bfhi(gg.x)); o.y = pk2(bflo(uu.y) * bflo(gg.y), bfhi(uu.y) * bfhi(gg.y)); o.z = pk2(bflo(uu.z) * bflo(gg.z), bfhi(uu.z) * bfhi(gg.z)); o.w = pk2(bflo(uu.w) * bflo(gg.w), bfhi(uu.w) * bfhi(gg.w));
                *(u32x4*)(MIX1 + token * 1024 + 512 + chb) = o; }
            __syncthreads();
        }
#endif
    }
    xcd_barrier(bar);
    STAMP(8);
    {
        pg8::Gemm g{MIX1, Wout1, M, 1024, 1024}; pg8::StaticOrder S; S.init(M, 1024, G, bx);
        pg8::EpiP p{}; p.hb = R1; p.o0 = R1; p.ss_out = ss + 3 * M;
        pg8::Epi<4> E{p};
        pg8::gemm_phase<pg8::Epi<4>, pg8::StaticOrder, true, true>(lds, g, S, E);
    }
    xcd_barrier(bar);
    STAMP(9);
    {
        pg8::Gemm g{R1, W1_1, M, FF, 1024}; pg8::StaticOrder S; S.init(M, FF, G, bx);
        pg8::EpiP p{}; p.ss = ss + 3 * M; p.o0 = U;
        pg8::Epi<2> E{p};
        pg8::gemm_phase<pg8::Epi<2>, pg8::StaticOrder, true, true>(lds, g, S, E);
    }
    xcd_barrier(bar);
    STAMP(10);
    {
        pg8::Gemm g{U, W2_1, M, 1024, FF}; pg8::StaticOrder S; S.init(M, 1024, G, bx);
        pg8::EpiP p{}; p.hb = R1; p.o0 = R1; p.ss_out = ss + 4 * M;
        pg8::Epi<4> E{p};
        pg8::gemm_phase<pg8::Epi<4>, pg8::StaticOrder, true, true>(lds, g, S, E);
    }
    xcd_barrier(bar);
    STAMP(11);
    {
        const float* fg = args.in[18];
        for (int row = gw; row < M; row += NGW) {
            const float r = rsqrtf(ss[4 * M + row] * (1.f / 1024.f) + EPS);
            f32x4* orow = (f32x4*)(out + (size_t)row * 1024) + lane; const f32x4* gr = (const f32x4*)fg + lane;
            const unsigned long long* hrow = (const unsigned long long*)(R1 + (size_t)row * 1024) + lane;
#pragma unroll
            for (int j = 0; j < 4; ++j) { const unsigned long long w = hrow[64 * j]; const unsigned lo = (unsigned)w, hv = (unsigned)(w >> 32);
                const f32x4 v = {bflo(lo), bfhi(lo), bflo(hv), bfhi(hv)}; orow[64 * j] = v * r * gr[64 * j]; }
        }
    }
#if defined(PROBE_LO)
    xcd_barrier(bar);
    STAMP(12);
    xcd_barrier(bar);
    {
        const float XA = floorf((float)(TSB[PROBE_HI] - TSB[PROBE_LO]) * 0.01f * (1.0f / PROBE_Q) + 0.5f) * PROBE_Q, YB = 0.f;
        float* o_ = args.out; const int g_ = blockIdx.x * 512 + threadIdx.x, n_ = gridDim.x * 512;
        (void)n_; (void)YB;
        if (g_ == 0) o_[0] = XA;
    }
#endif
}

extern "C" void kernel_launch(void* const* d_in, const int* in_sizes, int n_in, void* d_out, int out_size, void* d_ws, size_t ws_size, hipStream_t stream) {
    static int grid = 0;
    if (grid == 0) {
        if (n_in != 19 || out_size != M * DM || ws_size < WS_END) { fprintf(stderr, "kernel_launch: unexpected shapes (n_in %d out %d ws %zu)\n", n_in, out_size, ws_size); grid = -1; return; }
        int dev = 0, cus = 0, per_cu = 0;
        hipGetDevice(&dev); hipDeviceGetAttribute(&cus, hipDeviceAttributeMultiprocessorCount, dev);
        if (hipFuncSetAttribute((const void*)mk_fwd, hipFuncAttributeMaxDynamicSharedMemorySize, LDS_BYTES) != hipSuccess) { fprintf(stderr, "kernel_launch: hipFuncSetAttribute failed\n"); grid = -1; return; }
        if (hipOccupancyMaxActiveBlocksPerMultiprocessor(&per_cu, (const void*)mk_fwd, 512, LDS_BYTES) != hipSuccess || per_cu < 1) { fprintf(stderr, "kernel_launch: occupancy query says %d\n", per_cu); per_cu = 1; }
        (void)hipGetLastError();
        grid = cus;
        fprintf(stderr, "kernel_launch: cus %d per_cu %d grid %d\n", cus, per_cu, grid);
    }
    if (grid < 0) return;
    Args a{};
    for (int i = 0; i < 19; ++i) a.in[i] = (const float*)d_in[i];
    a.out = (float*)d_out; a.ws = (unsigned char*)d_ws;
    if (hipMemsetAsync((char*)d_ws + WS_CTL, 0, 16384, stream) != hipSuccess) { fprintf(stderr, "kernel_launch: memset failed\n"); return; }
    hipLaunchKernelGGL(mk_fwd, dim3(grid), dim3(512), LDS_BYTES, stream, a);
    hipError_t e = hipPeekAtLastError();
    if (e != hipSuccess) fprintf(stderr, "launch failed: %s (grid %d)\n", hipGetErrorString(e), grid);
}
```
